# Optimizing an MI355X kernel written in HIP

```python
import math
import jax, jax.numpy as jnp
from jax import lax
import numpy as np

D_MODEL = 1024
BATCH = 32
SEQ = 256
DEPTH = 4
DEC_BATCH = 2
DEC_SEQ = 1024
PAST_LEN = 256

GRID_W = 64
GROUP_W = D_MODEL // 4
A_HEADS = 4
A_V_DIM = GROUP_W // A_HEADS
A_QK_DIM = A_V_DIM // 2
B_GROUPS = 4
CHUNK = 128
C_KERNEL = 31
D_GROUPS = 4
D_FF = 4 * D_MODEL
ROPE_BASE = 10000.0
Q_BLOCK = 128
EPS = 1e-6
IN_W = 8 * GROUP_W
SPLITS = (GROUP_W, 2 * GROUP_W, 3 * GROUP_W, 5 * GROUP_W, 7 * GROUP_W)

kernel_name = "hybrid_diffusion_prefix_trunk_step"

F32 = jnp.float32


def rms_norm(x, g):
    xf = x.astype(F32)
    y = xf * lax.rsqrt(jnp.mean(xf * xf, axis=-1, keepdims=True) + EPS)
    return (y * g.astype(F32)).astype(x.dtype)


def layer_norm(x, g, b):
    xf = x.astype(F32)
    mu = jnp.mean(xf, axis=-1, keepdims=True)
    var = jnp.mean(jnp.square(xf - mu), axis=-1, keepdims=True)
    y = (xf - mu) * lax.rsqrt(var + EPS) * g.astype(F32) + b.astype(F32)
    return y.astype(x.dtype)


def axial_rope_tables(n_tokens):
    rows = n_tokens // GRID_W
    row = jnp.repeat(jnp.arange(rows, dtype=F32), GRID_W)
    col = jnp.tile(jnp.arange(GRID_W, dtype=F32), rows)
    nf = A_QK_DIM // 4
    inv = ROPE_BASE ** (-jnp.arange(nf, dtype=F32) / nf)
    ang = jnp.stack([row[:, None] * inv, col[:, None] * inv], axis=1)
    return jnp.cos(ang), jnp.sin(ang)


def apply_rope(x, cos, sin):
    shp = x.shape
    xr = x.astype(F32).reshape(shp[:-1] + (2, 2, A_QK_DIM // 4))
    a, b = xr[..., 0, :], xr[..., 1, :]
    cs, sn = cos[:, None, None], sin[:, None, None]
    rot = jnp.stack([a * cs - b * sn, b * cs + a * sn], axis=-2)
    return rot.reshape(shp).astype(x.dtype)


def diff_attention(q, k, v, lam):
    bn, lq = q.shape[:2]
    nb = lq // Q_BLOCK
    qb = q.reshape((bn, nb, Q_BLOCK) + q.shape[2:]).swapaxes(0, 1)
    kf, vf = k.astype(F32), v.astype(F32)
    scale = A_QK_DIM ** -0.5

    def block(qi):
        s = jnp.einsum('bqhcd,bkhcd->bchqk', qi.astype(F32), kf) * scale
        p = jax.nn.softmax(s, axis=-1)
        w = p[:, 0] - lam * p[:, 1]
        return jnp.einsum('bhqk,bkhd->bqhd', w, vf)

    o = lax.map(block, qb)
    return o.swapaxes(0, 1).reshape(bn, lq, A_HEADS, A_V_DIM)


def spatial_gating(u, v, g, b, w_s, b_s):
    bn, L, _ = u.shape
    vn = layer_norm(v, g, b)
    vc = vn.reshape(bn, L // CHUNK, CHUNK, B_GROUPS, GROUP_W // B_GROUPS)
    mixed = jnp.einsum('gpq,bnqgc->bnpgc', w_s, vc) + b_s.T[None, None, :, :, None]
    return u * mixed.reshape(bn, L, GROUP_W)


def conv_module(a, gate, w_dw, b_dw, g, b):
    h = a * jax.nn.sigmoid(gate)
    y = lax.conv_general_dilated(
        h, w_dw[:, None, :], window_strides=(1,),
        padding=[(C_KERNEL // 2, C_KERNEL // 2)],
        dimension_numbers=('NWC', 'WIO', 'NWC'),
        feature_group_count=GROUP_W) + b_dw
    return jax.nn.silu(layer_norm(y, g, b))


def fourier_mix(z):
    bn, L, _ = z.shape
    zg = z.reshape(bn, L, D_GROUPS, GROUP_W // D_GROUPS).astype(F32)
    f = jnp.fft.fftn(zg, axes=(1, 3), norm='ortho').real
    return f.reshape(bn, L, GROUP_W).astype(z.dtype)


def trunk_layer(x, cond, P, l, rope, ctx_k, ctx_v):
    bn, L, _ = x.shape
    mod = (jax.nn.silu(cond) @ P['w_ada'][l] + P['b_ada'][l])[:, None, :]
    sh1, sc1, gt1, sh2, sc2, gt2 = jnp.split(mod, 6, axis=-1)
    h = rms_norm(x, P['g_attn_norm'][l]) * (1 + sc1) + sh1
    z = h @ P['w_in'][l]
    zq, zk, zv, zb, zc, zd = jnp.split(z, SPLITS, axis=-1)

    q = rms_norm(zq.reshape(bn, L, A_HEADS, 2, A_QK_DIM), P['g_q'][l])
    k = rms_norm(zk.reshape(bn, L, A_HEADS, 2, A_QK_DIM), P['g_k'][l])
    v = zv.reshape(bn, L, A_HEADS, A_V_DIM)
    own_k, own_v = k, v
    if rope is not None:
        q = apply_rope(q, *rope)
        k = apply_rope(k, *rope)
    if ctx_k is not None:
        k = jnp.concatenate([ctx_k.astype(k.dtype), k], axis=1)
        v = jnp.concatenate([ctx_v.astype(v.dtype), v], axis=1)
    lam_init = 0.8 - 0.6 * math.exp(-0.3 * l)
    lam = (jnp.exp(jnp.sum(P['lam_q1'][l].astype(F32) * P['lam_k1'][l].astype(F32)))
           - jnp.exp(jnp.sum(P['lam_q2'][l].astype(F32) * P['lam_k2'][l].astype(F32)))
           + lam_init)
    o_a = rms_norm(diff_attention(q, k, v, lam), P['g_head'][l]) * (1.0 - lam_init)
    o_a = o_a.reshape(bn, L, GROUP_W).astype(x.dtype)

    ub, vb = jnp.split(jax.nn.gelu(zb), 2, axis=-1)
    o_b = spatial_gating(ub, vb, P['g_sg'][l], P['b_sg'][l], P['w_spatial'][l], P['b_spatial'][l])

    ac, gc = jnp.split(zc, 2, axis=-1)
    o_c = conv_module(ac, gc, P['w_dw'][l], P['b_dw'][l], P['g_conv'][l], P['b_conv'][l])

    o_d = fourier_mix(zd)

    mix = jnp.concatenate([o_a, o_b, o_c, o_d], axis=-1) @ P['w_out'][l]
    x = x + gt1 * mix
    h2 = rms_norm(x, P['g_mlp_norm'][l]) * (1 + sc2) + sh2
    ff = jnp.square(jax.nn.relu(h2 @ P['w_ff1'][l])) @ P['w_ff2'][l]
    x = x + gt2 * ff
    return x, own_k, own_v


def setup_inputs(seed: int = 0) -> dict:
    key = jax.random.key(seed)
    ks = jax.random.split(key, 32)
    D = D_MODEL

    def nrm(k, shape, s):
        return jax.random.normal(k, shape, F32) * s

    return {
        'x_prompt': nrm(ks[0], (BATCH, SEQ, D), 1.0),
        'x_sample': nrm(ks[1], (DEC_BATCH, DEC_SEQ, D), 1.0),
        'c': nrm(ks[2], (DEC_BATCH, D), 1.0),
        'cache_k': nrm(ks[3], (DEC_BATCH, DEPTH, PAST_LEN, A_HEADS, 2 * A_QK_DIM), 1.0),
        'cache_v': nrm(ks[4], (DEC_BATCH, DEPTH, PAST_LEN, A_HEADS, A_V_DIM), 1.0),
        'c_ctx': nrm(ks[5], (D,), 1.0),
        'w_ada': nrm(ks[6], (DEPTH, D, 6 * D), D ** -0.5),
        'b_ada': nrm(ks[7], (DEPTH, 6 * D), 0.02),
        'g_attn_norm': 1.0 + nrm(ks[8], (DEPTH, D), 0.05),
        'g_mlp_norm': 1.0 + nrm(ks[9], (DEPTH, D), 0.05),
        'w_in': nrm(ks[10], (DEPTH, D, IN_W), D ** -0.5),
        'g_q': 1.0 + nrm(ks[11], (DEPTH, A_QK_DIM), 0.05),
        'g_k': 1.0 + nrm(ks[12], (DEPTH, A_QK_DIM), 0.05),
        'lam_q1': nrm(ks[13], (DEPTH, A_QK_DIM), 0.1),
        'lam_k1': nrm(ks[14], (DEPTH, A_QK_DIM), 0.1),
        'lam_q2': nrm(ks[15], (DEPTH, A_QK_DIM), 0.1),
        'lam_k2': nrm(ks[16], (DEPTH, A_QK_DIM), 0.1),
        'g_head': 1.0 + nrm(ks[17], (DEPTH, A_V_DIM), 0.05),
        'g_sg': 1.0 + nrm(ks[18], (DEPTH, GROUP_W), 0.05),
        'b_sg': nrm(ks[19], (DEPTH, GROUP_W), 0.02),
        'w_spatial': nrm(ks[20], (DEPTH, B_GROUPS, CHUNK, CHUNK), CHUNK ** -0.5),
        'b_spatial': 1.0 + nrm(ks[21], (DEPTH, B_GROUPS, CHUNK), 0.05),
        'w_dw': nrm(ks[22], (DEPTH, C_KERNEL, GROUP_W), C_KERNEL ** -0.5),
        'b_dw': nrm(ks[23], (DEPTH, GROUP_W), 0.02),
        'g_conv': 1.0 + nrm(ks[24], (DEPTH, GROUP_W), 0.05),
        'b_conv': nrm(ks[25], (DEPTH, GROUP_W), 0.02),
        'w_out': nrm(ks[26], (DEPTH, D, D), D ** -0.5),
        'w_ff1': nrm(ks[27], (DEPTH, D, D_FF), D ** -0.5),
        'w_ff2': nrm(ks[28], (DEPTH, D_FF, D), D_FF ** -0.5),
    }


def reference(x_prompt, x_sample, c, cache_k, cache_v, c_ctx, w_ada, b_ada,
              g_attn_norm, g_mlp_norm, w_in, g_q, g_k, lam_q1, lam_k1, lam_q2, lam_k2,
              g_head, g_sg, b_sg, w_spatial, b_spatial, w_dw, b_dw, g_conv, b_conv,
              w_out, w_ff1, w_ff2):
    P = dict(w_ada=w_ada, b_ada=b_ada, g_attn_norm=g_attn_norm, g_mlp_norm=g_mlp_norm,
             w_in=w_in, g_q=g_q, g_k=g_k, lam_q1=lam_q1, lam_k1=lam_k1, lam_q2=lam_q2,
             lam_k2=lam_k2, g_head=g_head, g_sg=g_sg, b_sg=b_sg, w_spatial=w_spatial,
             b_spatial=b_spatial, w_dw=w_dw, b_dw=b_dw, g_conv=g_conv, b_conv=b_conv,
             w_out=w_out, w_ff1=w_ff1, w_ff2=w_ff2)
    rope = axial_rope_tables(x_sample.shape[1])
    ctx_cond = c_ctx[None, :]
    n_p, l_p = x_prompt.shape[:2]
    n_s, l_c = cache_k.shape[0], cache_k.shape[2]
    xp, xs = x_prompt, x_sample
    k_list, v_list = [], []
    for l in range(DEPTH):
        xp, k_l, v_l = trunk_layer(xp, ctx_cond, P, l, None, None, None)
        k_list.append(k_l.reshape(n_p, l_p, A_HEADS, 2 * A_QK_DIM))
        v_list.append(v_l)
        ck = cache_k[:, l].reshape(n_s, l_c, A_HEADS, 2, A_QK_DIM)
        xs, _, _ = trunk_layer(xs, c, P, l, rope, ck, cache_v[:, l])
    new_k = jnp.stack(k_list, axis=1)
    new_v = jnp.stack(v_list, axis=1)
    return (xp, xs, new_k, new_v)
```

```cpp
#include <hip/hip_runtime.h>
#include <hip/hip_cooperative_groups.h>
#include <cstdio>
#include <cstdint>
namespace cg = cooperative_groups;
namespace pg8 {
#define PG8_LAS __attribute__((address_space(3)))
typedef unsigned short bf16_t;
typedef short bf16x8 __attribute__((ext_vector_type(8)));
typedef float f32x4 __attribute__((ext_vector_type(4)));
typedef unsigned u32x4 __attribute__((ext_vector_type(4)));
constexpr int RSS_LDS_OFF = 131072 + 256;
constexpr int BM = 256, BK = 64, HALF = 128, HTB = HALF * BK * 2  , STAGE_BYTES = 8 * HTB, NXCD = 8, WGM = 8;

__host__ __device__ __forceinline__ int lds_byte(int r, int c) { const int st = (r >> 4) * 2 + (c >> 5), rr = r & 15, cc = c & 31, ob = rr * 64 + cc * 2; return st * 1024 + (ob ^ (((ob >> 9) & 1) << 5)); }
__host__ __device__ __forceinline__ void stage_rc(int b, int& R, int& C) { const int st = b / 1024, sb = b % 1024, swz = sb ^ (((sb >> 9) & 1) << 5); R = (st >> 1) * 16 + swz / 64; C = (st & 1) * 32 + (swz % 64) / 2; }
__host__ __device__ __forceinline__ int perm32(int rho) { const int n = rho >> 4, i = rho & 15; return 8 * (i >> 2) + 4 * n + (i & 3); }

struct Unit { int pm, pn; };
struct Gemm { const bf16_t* A; const bf16_t* Bt; int M, N, K; };

struct StaticOrder {
    int nM, nN, nwg, G, c;
    int wgm = WGM;
    __host__ __device__ void init(int M, int N, int G_, int c_) { nM = M / BM; nN = N / BM; nwg = nM * nN; G = G_; c = c_; }
    __host__ __device__ bool next(int i, Unit& u) const {
        const long L = (long)i * G + c; if (L >= nwg) return false;
        int wgid = (int)L; { const int q = nwg / NXCD, r = nwg % NXCD, xcd = wgid % NXCD, off = wgid / NXCD; wgid = (xcd < r ? xcd * (q + 1) : r * (q + 1) + (xcd - r) * q) + off; }
        const int nig = wgm * nN, gid = wgid / nig, fm = gid * wgm, gsz = (nM - fm) < wgm ? (nM - fm) : wgm;
        u.pm = fm + ((wgid % nig) % gsz); u.pn = (wgid % nig) / gsz; return true;
    }
    __device__ __forceinline__ void a_ready(const Unit&) const {}
    __device__ __forceinline__ void done(const Unit&) const {}
};

typedef __bf16 bf16v2_t __attribute__((ext_vector_type(2)));
typedef float f32v2_t __attribute__((ext_vector_type(2)));
__device__ __forceinline__ unsigned cvt_pk_bf16(float lo, float hi) { const bf16v2_t r = __builtin_convertvector((f32v2_t){lo, hi}, bf16v2_t); return __builtin_bit_cast(unsigned, r); }
typedef float f32x2 __attribute__((ext_vector_type(2)));
__device__ __forceinline__ float dot4(const f32x4 a) { return (a[0] * a[0] + a[1] * a[1]) + (a[2] * a[2] + a[3] * a[3]); }
__device__ __forceinline__ f32x4 shfl_xor4(const f32x4 v, int m) { f32x4 r; r[0] = __shfl_xor(v[0], m); r[1] = __shfl_xor(v[1], m); r[2] = __shfl_xor(v[2], m); r[3] = __shfl_xor(v[3], m); return r; }
__device__ __forceinline__ float gelu_tanh(float x) { const float u = 0.7978845608028654f * (x + 0.044715f * x * x * x); return x * __builtin_amdgcn_rcpf(1.0f + __expf(-2.0f * u)); }
__device__ __forceinline__ f32x4 gelu4(const f32x4 v) { f32x4 r; r[0] = gelu_tanh(v[0]); r[1] = gelu_tanh(v[1]); r[2] = gelu_tanh(v[2]); r[3] = gelu_tanh(v[3]); return r; }
__device__ __forceinline__ u32x4 pack8(const f32x4 v0, const f32x4 v1) { u32x4 w; w.x = cvt_pk_bf16(v0[0], v0[1]); w.y = cvt_pk_bf16(v0[2], v0[3]); w.z = cvt_pk_bf16(v1[0], v1[1]); w.w = cvt_pk_bf16(v1[2], v1[3]); return w; }

__device__ __forceinline__ float rinv_lds(const PG8_LAS float* rss_lds, int ai, int wr, int m, int fr, int fq) {
    const f32x4 s4 = ((const PG8_LAS f32x4*)rss_lds)[(ai * HALF + wr * 64 + m * 16 + fr) * 4 + fq]; float sr = (s4[0] + s4[1]) + (s4[2] + s4[3]); sr += __shfl_xor(sr, 16); sr += __shfl_xor(sr, 32); return rsqrtf(sr * (1.0f / 1024.0f) + 1e-6f); }
struct EpiG1 {
    static constexpr bool PERM = true, AFTER_DRAIN = false, NEEDS_RSS = true;
    bf16_t* Z; float* outk; float* outv; const float* gq; const float* gk; const float* rope; int layer;
    const float* rss; const float* cvec; const PG8_LAS float* rss_lds;
    __device__ __forceinline__ void operator()(const f32x4 (&acc)[2][2][4][2], const Unit& u, int wr, int wc, int fr, int fq) const {
        const int pn = u.pn, pm = u.pm;
        const int row0 = pm * BM + wr * 64 + fr;
        const bool latent = pm >= 32;
        const int colw = wc * 32 + 8 * fq;
        f32x4 cb[2][2];
        { const float* cp = cvec + (pm < 32 ? 0 : 1 + ((pm - 32) >> 2)) * 2304 + pn * 256 + colw;
#pragma unroll
          for (int bj = 0; bj < 2; ++bj) { cb[bj][0] = *(const f32x4*)(cp + bj * HALF); cb[bj][1] = *(const f32x4*)(cp + bj * HALF + 4); } }
        if (pn <= 1) {
            const float* gsrc = pn == 0 ? gq : gk;
            const f32x4 g0 = *(const f32x4*)(gsrc + 8 * fq), g1 = *(const f32x4*)(gsrc + 8 * fq + 4);
            const float qscale = pn == 0 ? (0.17677669529663687f * 1.4426950408889634f) : 1.0f;
            const float sgn = (fq & 1) ? 1.0f : -1.0f;
#pragma unroll
            for (int ai = 0; ai < 2; ++ai)
#pragma unroll
                for (int m = 0; m < 4; ++m) {
                    const int r = row0 + ai * HALF + m * 16; const float rv = rinv_lds(rss_lds, ai, wr, m, fr, fq);
                    f32x4 c0 = {1.f, 1.f, 1.f, 1.f}, c1 = c0, s0 = {0.f, 0.f, 0.f, 0.f}, s1 = s0;
                    if (latent) { const int t = (r - 8192) & 1023; const int pos = (fq >> 1) ? (t & 63) : (t >> 6); const float* rp = rope + pos * 16;
                        c0 = *(const f32x4*)(rp); c1 = *(const f32x4*)(rp + 4); s0 = *(const f32x4*)(rp + 8); s1 = *(const f32x4*)(rp + 12); }
#pragma unroll
                    for (int bj = 0; bj < 2; ++bj) {
                        f32x4 v0 = acc[ai][bj][m][0] * rv + cb[bj][0], v1 = acc[ai][bj][m][1] * rv + cb[bj][1];
                        float ss = dot4(v0) + dot4(v1);
                        ss += __shfl_xor(ss, 16); ss += __shfl_xor(ss, 32);
                        const float rinv = rsqrtf(ss * (1.0f / 32.0f) + 1e-6f);
                        v0 = v0 * rinv * g0; v1 = v1 * rinv * g1;
                        if (pn == 1 && !latent) { float* o = outk + ((size_t)((r >> 8) * 4 + layer) * 256 + (r & 255)) * 256 + bj * HALF + colw; *(f32x4*)o = v0; *(f32x4*)(o + 4) = v1; }
                        if (latent) { const f32x4 p0 = shfl_xor4(v0, 16), p1 = shfl_xor4(v1, 16); v0 = v0 * c0 + (p0 * s0) * sgn; v1 = v1 * c1 + (p1 * s1) * sgn; }
                        v0 = v0 * qscale; v1 = v1 * qscale;
                        *(u32x4*)(Z + (size_t)r * 2304 + pn * 256 + bj * HALF + colw) = pack8(v0, v1);
                    }
                }
        } else {
#pragma unroll
            for (int ai = 0; ai < 2; ++ai)
#pragma unroll
                for (int m = 0; m < 4; ++m) {
                    const int r = row0 + ai * HALF + m * 16; const float rv = rinv_lds(rss_lds, ai, wr, m, fr, fq);
#pragma unroll
                    for (int bj = 0; bj < 2; ++bj) {
                        f32x4 v0 = acc[ai][bj][m][0] * rv + cb[bj][0], v1 = acc[ai][bj][m][1] * rv + cb[bj][1];
                        if (pn == 2 && !latent) { float* o = outv + ((size_t)((r >> 8) * 4 + layer) * 256 + (r & 255)) * 256 + bj * HALF + colw; *(f32x4*)o = v0; *(f32x4*)(o + 4) = v1; }
                        if (pn == 3 || pn == 4) { v0 = gelu4(v0); v1 = gelu4(v1); }
                        *(u32x4*)(Z + (size_t)r * 2304 + pn * 256 + bj * HALF + colw) = pack8(v0, v1);
                    }
                }
        }
    }
};
struct EpiRes {
    static constexpr bool PERM = true, AFTER_DRAIN = false, NEEDS_RSS = false;
    const float* base0; const float* base1;
    const bf16_t* baseh;
    float* outf; bf16_t* outh;
    const float* gate;
    bf16_t* an; const float* gnorm; const float* scv; float* rss_out;
    __device__ __forceinline__ void operator()(const f32x4 (&acc)[2][2][4][2], const Unit& u, int wr, int wc, int fr, int fq) const {
        const int pm = u.pm; const int cond = pm < 32 ? 0 : 1 + ((pm - 32) >> 2);
        const int col0 = u.pn * BM + wc * 32 + 8 * fq;
        const float* gp = gate + cond * 6144 + col0;
        f32x4 gv[2][2];
#pragma unroll
        for (int bj = 0; bj < 2; ++bj)
#pragma unroll
            for (int n = 0; n < 2; ++n) gv[bj][n] = *(const f32x4*)(gp + bj * HALF + n * 4);
        const size_t rowbase = (size_t)(pm * BM) * 1024;
        const float* bs = pm < 32 ? base0 + rowbase : base1 + (rowbase - (size_t)8192 * 1024);
        f32x4 gs[2][2];
        if (an) {
#pragma unroll
            for (int bj = 0; bj < 2; ++bj)
#pragma unroll
                for (int n = 0; n < 2; ++n) gs[bj][n] = *(const f32x4*)(gnorm + col0 + bj * HALF + n * 4) * (*(const f32x4*)(scv + cond * 6144 + col0 + bj * HALF + n * 4) + 1.0f);
        }
#pragma unroll
        for (int ai = 0; ai < 2; ++ai)
#pragma unroll
            for (int m = 0; m < 4; ++m) { const size_t off = (size_t)(ai * HALF + wr * 64 + m * 16 + fr) * 1024 + col0; float ssq = 0.f;
#pragma unroll
                for (int bj = 0; bj < 2; ++bj) { const size_t o2 = off + bj * HALF; f32x4 b0, b1;
                    if (baseh) { const u32x4 w = *(const u32x4*)(baseh + rowbase + o2);
                        b0 = (f32x4){__uint_as_float(w.x << 16), __uint_as_float(w.x & 0xffff0000u), __uint_as_float(w.y << 16), __uint_as_float(w.y & 0xffff0000u)};
                        b1 = (f32x4){__uint_as_float(w.z << 16), __uint_as_float(w.z & 0xffff0000u), __uint_as_float(w.w << 16), __uint_as_float(w.w & 0xffff0000u)}; }
                    else { b0 = *(const f32x4*)(bs + o2); b1 = *(const f32x4*)(bs + o2 + 4); }
                    const f32x4 x0 = b0 + gv[bj][0] * acc[ai][bj][m][0], x1 = b1 + gv[bj][1] * acc[ai][bj][m][1];
                    if (outh) *(u32x4*)(outh + rowbase + o2) = pack8(x0, x1); else { *(f32x4*)(outf + rowbase + o2) = x0; *(f32x4*)(outf + rowbase + o2 + 4) = x1; }
                    if (an) { ssq += dot4(x0) + dot4(x1); *(u32x4*)(an + rowbase + o2) = pack8(x0 * gs[bj][0], x1 * gs[bj][1]); } }
                if (an) { ssq += __shfl_xor(ssq, 16); ssq += __shfl_xor(ssq, 32); if (fq == 0) rss_out[(size_t)(pm * BM + ai * HALF + wr * 64 + m * 16 + fr) * 16 + u.pn * 4 + wc] = ssq; } }
    }
};
struct EpiRelu2 {
    static constexpr bool PERM = true, AFTER_DRAIN = false, NEEDS_RSS = true;
    bf16_t* O; int ldc; const float* rss; const float* cvec; const PG8_LAS float* rss_lds;
    __device__ __forceinline__ void operator()(const f32x4 (&acc)[2][2][4][2], const Unit& u, int wr, int wc, int fr, int fq) const {
        const int row0 = u.pm * BM + wr * 64 + fr; const int col0 = u.pn * BM + wc * 32 + 8 * fq;
        f32x4 cb[2][2];
        { const float* cp = cvec + (u.pm < 32 ? 0 : 1 + ((u.pm - 32) >> 2)) * ldc + col0;
#pragma unroll
          for (int bj = 0; bj < 2; ++bj) { cb[bj][0] = *(const f32x4*)(cp + bj * HALF); cb[bj][1] = *(const f32x4*)(cp + bj * HALF + 4); } }
#pragma unroll
        for (int ai = 0; ai < 2; ++ai)
#pragma unroll
            for (int m = 0; m < 4; ++m) { bf16_t* rowp = O + (size_t)(row0 + ai * HALF + m * 16) * ldc + col0; const float rv = rinv_lds(rss_lds, ai, wr, m, fr, fq);
#pragma unroll
                for (int bj = 0; bj < 2; ++bj) { f32x4 v0 = acc[ai][bj][m][0] * rv + cb[bj][0], v1 = acc[ai][bj][m][1] * rv + cb[bj][1];
                    v0 = __builtin_elementwise_max(v0, (f32x4){0.f, 0.f, 0.f, 0.f}); v1 = __builtin_elementwise_max(v1, (f32x4){0.f, 0.f, 0.f, 0.f});
                    v0 = v0 * v0; v1 = v1 * v1; *(u32x4*)(rowp + bj * HALF) = pack8(v0, v1); } }
    }
};

template <class Epi, class Sched, bool ALIGN_EPI = false, bool SP2 = false>
__device__ __forceinline__ void gemm_phase(PG8_LAS unsigned char* lds, const Gemm g, const Sched& S, const Epi& E) {
    int tid_raw = threadIdx.x; asm volatile("" : "+v"(tid_raw));
    const int tid = tid_raw, wid = __builtin_amdgcn_readfirstlane(tid >> 6), lane = tid & 63, wr = wid >> 2, wc = wid & 3, fr = lane & 15, fq = lane >> 4;
    const int K = g.K, nt = K / BK;
    unsigned voffA[2], voffB[2];
#pragma unroll
    for (int i = 0; i < 2; ++i) { int R, C; stage_rc(tid * 16 + i * 8192, R, C); const int Rb = Epi::PERM ? ((R & ~31) + perm32(R & 31)) : R;
        voffA[i] = (unsigned)(R * K + C) * 2u; voffB[i] = (unsigned)(Rb * K + C) * 2u; }
    const size_t kstep = (size_t)(BK * 2);
    const size_t hstep = (size_t)HALF * K * 2;
    const size_t tstep = 2 * hstep;
    const unsigned ldsw = (unsigned)wid * 1024u;
    const int aoff = lds_byte(wr * 64 + fr, fq * 8), boff = lds_byte(wc * 32 + fr, fq * 8);
#define PG8_SA(b, h) (((b) * 2 + (h)) * HTB)
#define PG8_SB(b, h) ((4 + (b) * 2 + (h)) * HTB)
#define PG8_STAGE(bufoff, gbase, voff) do { _Pragma("unroll") for (int _i = 0; _i < 2; ++_i) \
        __builtin_amdgcn_global_load_lds((const unsigned*)((const char*)(gbase) + (voff)[_i]), (PG8_LAS unsigned*)(lds + (bufoff) + ldsw + _i * 8192), 16, 0, 0); } while (0)
#define PG8_LDA(dst, b, h) do { _Pragma("unroll") for (int m = 0; m < 4; ++m) _Pragma("unroll") for (int k = 0; k < 2; ++k) dst[m][k] = *(const PG8_LAS bf16x8*)(lds + PG8_SA(b, h) + aoff + m * 2048 + k * 1024); } while (0)
#define PG8_LDB(dst, b, h) do { _Pragma("unroll") for (int n = 0; n < 2; ++n) _Pragma("unroll") for (int k = 0; k < 2; ++k) dst[n][k] = *(const PG8_LAS bf16x8*)(lds + PG8_SB(b, h) + boff + n * 2048 + k * 1024); } while (0)
#define PG8_MMA(ai, bj, At, Bt) do { __builtin_amdgcn_s_setprio(1); _Pragma("unroll") for (int m = 0; m < 4; ++m) _Pragma("unroll") for (int n = 0; n < 2; ++n) _Pragma("unroll") for (int k = 0; k < 2; ++k) \
        acc[ai][bj][m][n] = __builtin_amdgcn_mfma_f32_16x16x32_bf16(Bt[n][k], At[m][k], acc[ai][bj][m][n], 0, 0, 0); __builtin_amdgcn_s_setprio(0); } while (0)
#define PG8_WAIT_V(n) asm volatile("s_waitcnt vmcnt(" #n ")" ::: "memory")
#define PG8_WAIT_L(n) asm volatile("s_waitcnt lgkmcnt(" #n ")" ::: "memory")
#define PG8_BAR __builtin_amdgcn_s_barrier()
#define PG8_SCHED __builtin_amdgcn_sched_barrier(0)
    Unit cur, nxt; int ui = 0;
    if (!S.next(0, cur)) return;
#define PG8_RSS_DMA(unit) do { const char* rsrc_ = (const char*)E.rss + (size_t)(unit).pm * (BM * 64) + (size_t)tid * 16; \
        _Pragma("unroll") for (int _i = 0; _i < 2; ++_i) __builtin_amdgcn_global_load_lds((const unsigned*)(rsrc_ + _i * 8192), (PG8_LAS unsigned*)(lds + RSS_LDS_OFF + ldsw + _i * 8192), 16, 0, 0); } while (0)
    if constexpr (Epi::NEEDS_RSS) { static_assert(ALIGN_EPI, "the row-statistics panel hand-over relies on the aligned epilogues"); PG8_RSS_DMA(cur); }
    f32x4 acc[2][2][4][2];
#pragma unroll
    for (int a = 0; a < 2; ++a)
#pragma unroll
        for (int b = 0; b < 2; ++b)
#pragma unroll
            for (int m = 0; m < 4; ++m)
#pragma unroll
                for (int n = 0; n < 2; ++n) acc[a][b][m][n] = (f32x4){0.f, 0.f, 0.f, 0.f};
    bf16x8 At[4][2], B0[2][2], B1[2][2];
    const char* cA = (const char*)g.A + (size_t)cur.pm * tstep; const char* cB = (const char*)g.Bt + (size_t)cur.pn * tstep;
    S.a_ready(cur);
    if constexpr (SP2) {
        PG8_STAGE(PG8_SB(0, 0), cB, voffB); PG8_STAGE(PG8_SB(0, 1), cB + hstep, voffB); PG8_STAGE(PG8_SA(0, 0), cA, voffA); PG8_STAGE(PG8_SA(0, 1), cA + hstep, voffA);
        if (wr == 1) PG8_BAR;
        PG8_WAIT_V(2); PG8_BAR;
        PG8_STAGE(PG8_SB(1, 0), cB + kstep, voffB); PG8_STAGE(PG8_SA(1, 0), cA + kstep, voffA); PG8_STAGE(PG8_SB(1, 1), cB + hstep + kstep, voffB);
        PG8_WAIT_V(6); PG8_BAR;
    } else {
        PG8_STAGE(PG8_SB(0, 0), cB, voffB); PG8_STAGE(PG8_SA(0, 0), cA, voffA); PG8_STAGE(PG8_SB(0, 1), cB + hstep, voffB); PG8_STAGE(PG8_SA(0, 1), cA + hstep, voffA);
        if (wr == 1) PG8_BAR;
        PG8_WAIT_V(4); PG8_BAR;
        PG8_STAGE(PG8_SB(1, 0), cB + kstep, voffB); PG8_STAGE(PG8_SA(1, 0), cA + kstep, voffA); PG8_STAGE(PG8_SB(1, 1), cB + hstep + kstep, voffB);
        PG8_WAIT_V(6); PG8_BAR;
    }
    for (;;) {
        const bool has_next = S.next(ui + 1, nxt);
        const char* nA = has_next ? (const char*)g.A + (size_t)nxt.pm * tstep : cA; const char* nB = has_next ? (const char*)g.Bt + (size_t)nxt.pn * tstep : cB;
        for (int t = 0; t < nt; t += 2) {
            const bool last = (t == nt - 2);
            const char* a1 = cA + (size_t)(t + 1) * kstep;
            const char* a2 = last ? nA : cA + (size_t)(t + 2) * kstep; const char* b2 = last ? nB : cB + (size_t)(t + 2) * kstep;
            const char* a3 = a2 + kstep; const char* b3 = b2 + kstep;
            if (last && has_next) S.a_ready(nxt);
            if constexpr (SP2) {
            PG8_LDB(B0, 0, 0); PG8_LDB(B1, 0, 1); PG8_SCHED; PG8_LDA(At, 0, 0); PG8_STAGE(PG8_SA(1, 1), a1 + hstep, voffA);
            PG8_WAIT_V(8); PG8_WAIT_L(0); PG8_BAR;
            PG8_MMA(0, 0, At, B0); PG8_MMA(0, 1, At, B1); PG8_BAR; PG8_SCHED;
            PG8_LDA(At, 0, 1); PG8_STAGE(PG8_SB(0, 0), b2, voffB); PG8_STAGE(PG8_SB(0, 1), b2 + hstep, voffB); PG8_STAGE(PG8_SA(0, 0), a2, voffA);
            PG8_WAIT_V(8); PG8_WAIT_L(0); PG8_BAR; PG8_MMA(1, 0, At, B0); PG8_MMA(1, 1, At, B1); PG8_BAR; PG8_SCHED;
            PG8_LDB(B0, 1, 0); PG8_LDB(B1, 1, 1); PG8_SCHED; PG8_LDA(At, 1, 0); PG8_STAGE(PG8_SA(0, 1), a2 + hstep, voffA);
            PG8_WAIT_V(8); PG8_WAIT_L(0); PG8_BAR; PG8_MMA(0, 0, At, B0); PG8_MMA(0, 1, At, B1); PG8_BAR; PG8_SCHED;
            PG8_LDA(At, 1, 1); PG8_STAGE(PG8_SB(1, 0), b3, voffB); PG8_STAGE(PG8_SB(1, 1), b3 + hstep, voffB); PG8_STAGE(PG8_SA(1, 0), a3, voffA);
            PG8_WAIT_V(8); PG8_WAIT_L(0); PG8_BAR; PG8_MMA(1, 0, At, B0); PG8_MMA(1, 1, At, B1); PG8_BAR; PG8_SCHED;
            } else {
            PG8_LDB(B0, 0, 0); PG8_SCHED; PG8_LDA(At, 0, 0); PG8_STAGE(PG8_SA(1, 1), a1 + hstep, voffA);
            PG8_WAIT_L(8); PG8_BAR; PG8_WAIT_L(0); PG8_MMA(0, 0, At, B0); PG8_BAR; PG8_SCHED;
            PG8_LDB(B1, 0, 1); PG8_STAGE(PG8_SB(0, 0), b2, voffB);
            PG8_BAR; PG8_WAIT_L(0); PG8_MMA(0, 1, At, B1); PG8_BAR;
            PG8_LDA(At, 0, 1); PG8_STAGE(PG8_SA(0, 0), a2, voffA);
            PG8_BAR; PG8_WAIT_L(0); PG8_MMA(1, 0, At, B0); PG8_BAR; PG8_SCHED;
            PG8_STAGE(PG8_SB(0, 1), b2 + hstep, voffB);
            PG8_WAIT_V(6); PG8_BAR; PG8_MMA(1, 1, At, B1); PG8_BAR;
            PG8_LDB(B0, 1, 0); PG8_SCHED; PG8_LDA(At, 1, 0); PG8_STAGE(PG8_SA(0, 1), a2 + hstep, voffA);
            PG8_WAIT_L(8); PG8_BAR; PG8_WAIT_L(0); PG8_MMA(0, 0, At, B0); PG8_BAR; PG8_SCHED;
            PG8_LDB(B1, 1, 1); PG8_STAGE(PG8_SB(1, 0), b3, voffB);
            PG8_BAR; PG8_WAIT_L(0); PG8_MMA(0, 1, At, B1); PG8_BAR;
            PG8_LDA(At, 1, 1); PG8_STAGE(PG8_SA(1, 0), a3, voffA);
            PG8_BAR; PG8_WAIT_L(0); PG8_MMA(1, 0, At, B0); PG8_BAR; PG8_SCHED;
            PG8_STAGE(PG8_SB(1, 1), b3 + hstep, voffB);
            PG8_WAIT_V(6); PG8_BAR; PG8_MMA(1, 1, At, B1); PG8_BAR;
            }
        }
        if constexpr (ALIGN_EPI) { if (wr == 0) PG8_BAR; }
        if constexpr (!Epi::AFTER_DRAIN) { E(acc, cur, wr, wc, fr, fq); S.done(cur); }
        if (!has_next) break;
#pragma unroll
        for (int a = 0; a < 2; ++a)
#pragma unroll
            for (int b = 0; b < 2; ++b)
#pragma unroll
                for (int m = 0; m < 4; ++m)
#pragma unroll
                    for (int n = 0; n < 2; ++n) acc[a][b][m][n] = (f32x4){0.f, 0.f, 0.f, 0.f};
        cur = nxt; cA = nA; cB = nB; ++ui;
        if constexpr (Epi::NEEDS_RSS) { PG8_BAR; PG8_RSS_DMA(cur); }
        if constexpr (ALIGN_EPI) { if (wr == 1) PG8_BAR; }
    }
    PG8_WAIT_V(0);
    if constexpr (!ALIGN_EPI) { if (wr == 0) PG8_BAR; }
    PG8_BAR;
    if constexpr (Epi::AFTER_DRAIN) { E.fused(acc, cur, wr, wc, fr, fq, lds, wid, lane); S.done(cur); }
#undef PG8_RSS_DMA
#undef PG8_SA
#undef PG8_SB
#undef PG8_STAGE
#undef PG8_LDA
#undef PG8_LDB
#undef PG8_MMA
#undef PG8_WAIT_V
#undef PG8_WAIT_L
#undef PG8_BAR
#undef PG8_SCHED
}
}
#define LAS __attribute__((address_space(3)))
typedef unsigned short bf16_t;
typedef unsigned v4u __attribute__((ext_vector_type(4)));
typedef unsigned v2u __attribute__((ext_vector_type(2)));
typedef float f32x4 __attribute__((ext_vector_type(4)));
typedef short bf16x8 __attribute__((ext_vector_type(8)));
#define MFMA16(a, b, c) __builtin_amdgcn_mfma_f32_16x16x32_bf16((a), (b), (c), 0, 0, 0)
#define LDS_WAIT() asm volatile("s_waitcnt lgkmcnt(0)" ::: "memory")

constexpr int M = 10240, DM = 1024, NZ = 2304, FF = 4096, NL = 4, MCTX = 8192;
constexpr int LDS_BYTES = 131072 + 256 + 16384;
constexpr size_t al256(size_t x) { return (x + 255) & ~(size_t)255; }
constexpr size_t WS_BAR = 0;
constexpr size_t WS_MOD = 16384;
constexpr size_t MOD_BYTES = (size_t)4 * 3 * 6144 * 4;
constexpr size_t WS_ROPE = al256(WS_MOD + MOD_BYTES);
constexpr size_t WS_T256 = al256(WS_ROPE + 64 * 16 * 4);
constexpr size_t WS_T1024 = al256(WS_T256 + (size_t)256 * 512 * 2);
constexpr size_t WS_KC = al256(WS_T1024 + (size_t)1024 * 2048 * 2);
constexpr size_t WS_VC = al256(WS_KC + (size_t)2 * 4 * 256 * 256 * 2);
constexpr size_t WS_WSP = al256(WS_VC + (size_t)2 * 4 * 256 * 256 * 2);
constexpr size_t WS_WIN = al256(WS_WSP + (size_t)4 * 4 * 128 * 128 * 2);
constexpr size_t WS_WOUT = al256(WS_WIN + (size_t)4 * 2304 * 1024 * 2);
constexpr size_t WS_W1 = al256(WS_WOUT + (size_t)4 * 1024 * 1024 * 2);
constexpr size_t WS_W2 = al256(WS_W1 + (size_t)4 * 4096 * 1024 * 2);
constexpr size_t WS_XN = al256(WS_W2 + (size_t)4 * 4096 * 1024 * 2);
constexpr size_t WS_Z = al256(WS_XN + (size_t)M * 1024 * 2);
constexpr size_t WS_MIXC = al256(WS_Z + (size_t)M * 2304 * 2);
constexpr size_t WS_X1 = al256(WS_MIXC + (size_t)M * 1024 * 2);
constexpr size_t WS_X = al256(WS_X1 + (size_t)M * 1024 * 4);
constexpr size_t WS_HB = al256(WS_X + (size_t)M * 1024 * 4);
constexpr size_t WS_RSS1 = al256(WS_HB + (size_t)M * 4096 * 2);
constexpr size_t WS_RSS2 = al256(WS_RSS1 + (size_t)M * 16 * 4);
constexpr size_t WS_CV1 = al256(WS_RSS2 + (size_t)M * 16 * 4);
constexpr size_t WS_CV2 = al256(WS_CV1 + (size_t)4 * 3 * 2304 * 4);
constexpr size_t WS_END = al256(WS_CV2 + (size_t)4 * 3 * 4096 * 4);

struct Args { const float* in[29]; float* out; unsigned char* ws; int ph_lo, ph_hi; };
static_assert(sizeof(Args) == 29 * 8 + 8 + 8 + 8, "Args has no padding");

__device__ __forceinline__ unsigned f2bf(float f) { unsigned u = __float_as_uint(f); return (u + 0x7fffu + ((u >> 16) & 1u)) >> 16; }
__device__ __forceinline__ unsigned pk2(float lo, float hi) { return pg8::cvt_pk_bf16(lo, hi); }
__device__ __forceinline__ float bflo(unsigned w) { return __uint_as_float(w << 16); }
__device__ __forceinline__ float bfhi(unsigned w) { return __uint_as_float(w & 0xffff0000u); }
__device__ __forceinline__ float bf2f(bf16_t b) { return __uint_as_float((unsigned)b << 16); }
__device__ __forceinline__ float wave_sum(float v) {
#pragma unroll
    for (int o = 1; o < 64; o <<= 1) v += __shfl_xor(v, o);
    return v;
}
__device__ __forceinline__ float sigmoidf_(float x) { return __builtin_amdgcn_rcpf(1.0f + __expf(-x)); }

#define RLX_AGENT __ATOMIC_RELAXED, __HIP_MEMORY_SCOPE_AGENT
#define XB_TMO      128
#define XB_XCNT(j)  (256  + 64 * (j))
#define XB_XSUB(j)  (1280 + 64 * (j))
#define XB_XGEN(j)  (2304 + 64 * (j))
#define XB_TOP      3328
#define XB_TOPGEN   3392
#define XCD_BAR_WORDS 3456
#define XB_SPIN_CAP (1u << 18)

__device__ __forceinline__ unsigned xb_ld(unsigned* p)              { return __hip_atomic_load(p, __ATOMIC_RELAXED, __HIP_MEMORY_SCOPE_AGENT); }
__device__ __forceinline__ unsigned xb_add(unsigned* p, unsigned v) { return __hip_atomic_fetch_add(p, v, __ATOMIC_RELAXED, __HIP_MEMORY_SCOPE_AGENT); }
__device__ __forceinline__ unsigned xb_xcc_id() { return (unsigned)__builtin_amdgcn_s_getreg((3 << 11) | 20) & 0xFu; }
#define XB_SPIN(cond, bar) do { unsigned _sp = 0; while (cond) { __builtin_amdgcn_s_sleep(1); \
    if ((++_sp & 255u) == 0u) { if (xb_ld(&(bar)[XB_TMO])) break; if (_sp > XB_SPIN_CAP) { atomicAdd(&(bar)[XB_TMO], 1u); break; } } } } while (0)

struct XcdBarrier {
    unsigned* bar; unsigned x;
    volatile LAS unsigned* st;
};

__device__ __forceinline__ XcdBarrier xcd_barrier_post(unsigned* bar, volatile LAS unsigned* st) {
    XcdBarrier b; b.bar = bar; b.x = xb_xcc_id(); b.st = st;
    if (threadIdx.x == 0) (void)xb_add(&bar[XB_XCNT(b.x)], 1u);
    return b;
}
__device__ __forceinline__ void xcd_barrier_complete(unsigned* bar, unsigned x, unsigned& nloc, unsigned& nx) {
    const unsigned G = gridDim.x * gridDim.y * gridDim.z;
    unsigned sum, cnt, mine, sp = 0u;
    for (;;) {
        sum = 0u; cnt = 0u; mine = 0u;
#pragma unroll
        for (unsigned j = 0; j < 16; ++j) { const unsigned c = xb_ld(&bar[XB_XCNT(j)]); sum += c; cnt += (c > 0u) ? 1u : 0u; mine = (j == x) ? c : mine; }
        if (sum == G) break;
        __builtin_amdgcn_s_sleep(1);
        if ((++sp & 255u) == 0u) { if (xb_ld(&bar[XB_TMO])) break; if (sp > XB_SPIN_CAP) { atomicAdd(&bar[XB_TMO], 1u); break; } }
    }
    nloc = mine > 0u ? mine : 1u; nx = cnt > 0u ? cnt : 1u;
}

__device__ __forceinline__ void xcd_barrier(const XcdBarrier& b) {
    asm volatile("s_waitcnt vmcnt(0)" ::: "memory");
    __syncthreads();
    if (threadIdx.x == 0) {
        unsigned* bar = b.bar;
        __builtin_amdgcn_s_waitcnt(0);
        unsigned nloc = b.st[0], nx = b.st[1];
        if (nloc == 0u) { xcd_barrier_complete(bar, b.x, nloc, nx); b.st[0] = nloc; b.st[1] = nx; }
        const unsigned old = xb_add(&bar[XB_XSUB(b.x)], 1u);
        const unsigned gen = old / nloc;
        if (old + 1u == (gen + 1u) * nloc) {
            __builtin_amdgcn_fence(__ATOMIC_RELEASE, "agent");
            asm volatile("s_waitcnt vmcnt(0)" ::: "memory");
            const unsigned og = xb_add(&bar[XB_TOP], 1u);
            const unsigned tg = og / nx;
            if (og + 1u == (tg + 1u) * nx) xb_add(&bar[XB_TOPGEN], 1u);
            else XB_SPIN(xb_ld(&bar[XB_TOPGEN]) == tg, bar);
            __builtin_amdgcn_fence(__ATOMIC_ACQUIRE, "agent");
            xb_add(&bar[XB_XGEN(b.x)], 1u);
            asm volatile("s_waitcnt vmcnt(0)" ::: "memory");
        } else {
            __builtin_amdgcn_fence(__ATOMIC_ACQUIRE, "agent");
            XB_SPIN(xb_ld(&bar[XB_XGEN(b.x)]) == gen, bar);
            asm volatile("s_waitcnt vmcnt(0)" ::: "memory");
        }
    }
    __syncthreads();
}

__device__ __forceinline__ void transpose_item(const float* W, int K, int ldw, int nblk, bf16_t* WT, LAS float* scr, int item, int lane) {
    const int kb = item / nblk, nb = item % nblk, k0 = 64 * kb, n0 = 32 * nb;
    float wv[32];
#pragma unroll
    for (int i = 0; i < 32; ++i) wv[i] = W[(size_t)(k0 + 2 * i + (lane >> 5)) * ldw + n0 + (lane & 31)];
#pragma unroll
    for (int i = 0; i < 32; ++i) scr[(2 * i + (lane >> 5)) * 33 + (lane & 31)] = wv[i];
    LDS_WAIT(); asm volatile("" ::: "memory");
    const int c = lane & 7;
#pragma unroll
    for (int j = 0; j < 4; ++j) { const int n = (lane >> 3) + 8 * j; const LAS float* s = scr + (8 * c) * 33 + n;
        v4u o; o.x = pk2(s[0 * 33], s[1 * 33]); o.y = pk2(s[2 * 33], s[3 * 33]); o.z = pk2(s[4 * 33], s[5 * 33]); o.w = pk2(s[6 * 33], s[7 * 33]);
        *(v4u*)(WT + (size_t)(n0 + n) * K + k0 + 8 * c) = o; }
    LDS_WAIT(); asm volatile("" ::: "memory");
}

__device__ __forceinline__ void weights_layer(const Args& a, LAS unsigned char* lds, int l, int vb, int NB, int tid, int lane, int wave) {
    unsigned char* ws = a.ws;
    const int gw = vb * 8 + wave, NGW = NB * 8;
    LAS float* scr = (LAS float*)(lds + wave * 16384);
    const float* w_in = a.in[10] + (size_t)l * 1024 * 2048; const float* w_out = a.in[26] + (size_t)l * 1024 * 1024; const float* w_ff1 = a.in[27] + (size_t)l * 1024 * 4096; const float* w_ff2 = a.in[28] + (size_t)l * 4096 * 1024;
    bf16_t* WinT = (bf16_t*)(ws + WS_WIN) + (size_t)l * 2304 * 1024; bf16_t* WoutT = (bf16_t*)(ws + WS_WOUT) + (size_t)l * 1024 * 1024; bf16_t* W1T = (bf16_t*)(ws + WS_W1) + (size_t)l * 4096 * 1024; bf16_t* W2T = (bf16_t*)(ws + WS_W2) + (size_t)l * 1024 * 4096;
    constexpr int I_IN = 16 * 56, I_OUT = 16 * 32, I_F1 = 16 * 128, I_F2 = 64 * 32, I_L = I_IN + I_OUT + I_F1 + I_F2;
    for (int it = gw; it < I_L; it += NGW) {
        int r = it;
        if (r < I_IN) { transpose_item(w_in, 1024, 2048, 56, WinT, scr, r, lane); continue; } r -= I_IN;
        if (r < I_OUT) { transpose_item(w_out, 1024, 1024, 32, WoutT, scr, r, lane); continue; } r -= I_OUT;
        if (r < I_F1) { transpose_item(w_ff1, 1024, 4096, 128, W1T, scr, r, lane); continue; } r -= I_F1;
        transpose_item(w_ff2, 4096, 1024, 32, W2T, scr, r, lane);
    }
    __syncthreads();
    for (int it = vb; it < 128; it += NB) {
        const int g = (it >> 5) & 3, kb = it & 31, k0 = kb * 32;
        LAS float* wt = (LAS float*)lds; LAS float* tw = wt + 2048;
        *(LAS f32x4*)(wt + tid * 4) = *(const f32x4*)(w_in + ((size_t)k0 + (tid >> 4)) * 2048 + 1792 + g * 64 + (tid & 15) * 4);
        if (tid < 64) { tw[tid] = __builtin_amdgcn_cosf((float)tid * (1.0f / 64.0f)); tw[64 + tid] = __builtin_amdgcn_sinf((float)tid * (1.0f / 64.0f)); }
        __syncthreads();
        const int m = tid & 63, cs = (tid >> 6) & 1, kq = tid >> 7;
        float o[8];
#pragma unroll
        for (int kk = 0; kk < 8; ++kk) o[kk] = 0.f;
        for (int c = 0; c < 64; ++c) { const float t = tw[cs * 64 + ((m * c) & 63)];
#pragma unroll
            for (int kk = 0; kk < 8; ++kk) o[kk] += wt[(kq * 8 + kk) * 64 + c] * t; }
        v4u pk; pk.x = pk2(o[0], o[1]); pk.y = pk2(o[2], o[3]); pk.z = pk2(o[4], o[5]); pk.w = pk2(o[6], o[7]);
        *(v4u*)(WinT + ((size_t)1792 + cs * 256 + g * 64 + m) * 1024 + k0 + kq * 8) = pk;
        __syncthreads();
    }
}

__device__ __forceinline__ void mod_items(const Args& a, int l_lo, int l_hi, int vw, int NW, int lane) {
    float* mod = (float*)(a.ws + WS_MOD);
    for (int it = l_lo * 384 + vw; it < l_hi * 384; it += NW) {
        const int l = it / 384, cb = it % 384;
        const int ks = lane >> 2, col = cb * 16 + (lane & 3) * 4;
        f32x4 a0 = {0.f, 0.f, 0.f, 0.f}, a1 = a0, a2 = a0;
        const float* wp = a.in[6] + ((size_t)l * 1024 + ks) * 6144 + col;
#pragma unroll 16
        for (int kk = 0; kk < 64; ++kk) { const int k = kk * 16 + ks; const f32x4 w = *(const f32x4*)(wp + (size_t)kk * 16 * 6144);
            const float x0 = a.in[5][k], x1 = a.in[2][k], x2 = a.in[2][1024 + k];
            a0 += w * (x0 * sigmoidf_(x0)); a1 += w * (x1 * sigmoidf_(x1)); a2 += w * (x2 * sigmoidf_(x2)); }
#pragma unroll
        for (int o = 4; o < 64; o <<= 1)
#pragma unroll
            for (int j = 0; j < 4; ++j) { a0[j] += __shfl_xor(a0[j], o); a1[j] += __shfl_xor(a1[j], o); a2[j] += __shfl_xor(a2[j], o); }
        if (ks == 0) { const f32x4 bb = *(const f32x4*)(a.in[7] + (size_t)l * 6144 + col); float* mp = mod + (size_t)(l * 3) * 6144 + col;
            *(f32x4*)mp = a0 + bb; *(f32x4*)(mp + 6144) = a1 + bb; *(f32x4*)(mp + 2 * 6144) = a2 + bb; }
    }
}

__device__ __forceinline__ void p0_prologue(const Args& a, LAS unsigned char* lds, int tid, int lane, int wave) {
    unsigned char* ws = a.ws;
    const int gw = blockIdx.x * 8 + wave, NGW = gridDim.x * 8;
    float* mod = (float*)(ws + WS_MOD);
    mod_items(a, 0, NL, gw, NGW, lane);
    { const int nlw = (int)gridDim.x > 160 ? 1 : NL;
      for (int lw = 0; lw < nlw; ++lw) { weights_layer(a, lds, lw, blockIdx.x, gridDim.x, tid, lane, wave); __syncthreads(); } }
    const int gt = blockIdx.x * 512 + tid, GT = gridDim.x * 512;
    { const f32x4* ck = (const f32x4*)a.in[3]; const f32x4* cv = (const f32x4*)a.in[4]; v2u* KC = (v2u*)(ws + WS_KC); v2u* VC = (v2u*)(ws + WS_VC);
      for (int i = gt; i < 524288 / 4; i += GT) { const f32x4 k = ck[i], v = cv[i]; KC[i] = (v2u){pk2(k[0], k[1]), pk2(k[2], k[3])}; VC[i] = (v2u){pk2(v[0], v[1]), pk2(v[2], v[3])}; }
      const f32x4* wsp = (const f32x4*)a.in[20]; v2u* WSP = (v2u*)(ws + WS_WSP);
      for (int i = gt; i < 262144 / 4; i += GT) { const f32x4 k = wsp[i]; WSP[i] = (v2u){pk2(k[0], k[1]), pk2(k[2], k[3])}; } }
    { bf16_t* T256 = (bf16_t*)(ws + WS_T256);
      for (int i = gt; i < 256 * 512; i += GT) { const int k = i >> 9, j = i & 511, n = j & 255, r = (k * n) & 255; const float fr = (float)r * (1.0f / 256.0f);
          const float v = (j >= 256) ? -__builtin_amdgcn_sinf(fr) : __builtin_amdgcn_cosf(fr); T256[i] = (bf16_t)f2bf(v * (1.0f / 128.0f)); }
      bf16_t* T1024 = (bf16_t*)(ws + WS_T1024);
      for (int i = gt; i < 1024 * 2048; i += GT) { const int k = i >> 11, j = i & 2047, n = j & 1023, r = (k * n) & 1023; const float fr = (float)r * (1.0f / 1024.0f);
          const float v = (j >= 1024) ? -__builtin_amdgcn_sinf(fr) : __builtin_amdgcn_cosf(fr); T1024[i] = (bf16_t)f2bf(v * (1.0f / 256.0f)); }
      float* rope = (float*)(ws + WS_ROPE);
      if (gt < 512) { const int pos = gt >> 3, f = gt & 7; const float inv = __builtin_amdgcn_exp2f(-(float)f * 1.6609640474436813f); float rev = (float)pos * inv * 0.15915494309189535f; rev -= floorf(rev);
          rope[pos * 16 + f] = __builtin_amdgcn_cosf(rev); rope[pos * 16 + 8 + f] = __builtin_amdgcn_sinf(rev); } }
}

__device__ __forceinline__ void norm_phase(const float* src0, const float* src1, const float* gnorm, const float* modl, int shi, int sci, bf16_t* XN, int lane, int wave) {
    const int gw = blockIdx.x * 8 + wave, NGW = gridDim.x * 8;
    for (int row = gw; row < M; row += NGW) {
        const float* xr = row < MCTX ? src0 + (size_t)row * 1024 : src1 + (size_t)(row - MCTX) * 1024;
        const int cond = row < MCTX ? 0 : 1 + ((row - MCTX) >> 10);
        const float* mp = modl + cond * 6144;
        f32x4 v[4]; float s = 0.f;
#pragma unroll
        for (int j = 0; j < 4; ++j) { v[j] = ((const f32x4*)xr)[lane + 64 * j]; s += (v[j][0] * v[j][0] + v[j][1] * v[j][1]) + (v[j][2] * v[j][2] + v[j][3] * v[j][3]); }
        const float rinv = rsqrtf(wave_sum(s) * (1.0f / 1024.0f) + 1e-6f);
#pragma unroll
        for (int j = 0; j < 4; ++j) { const int col = 4 * (lane + 64 * j);
            const f32x4 g = *(const f32x4*)(gnorm + col), sc = *(const f32x4*)(mp + sci * 1024 + col), sh = *(const f32x4*)(mp + shi * 1024 + col);
            const f32x4 h = v[j] * rinv * g * (sc + 1.0f) + sh;
            *(v2u*)(XN + (size_t)row * 1024 + col) = (v2u){pk2(h[0], h[1]), pk2(h[2], h[3])}; }
    }
}

__device__ __forceinline__ void cvec_layer(const Args& a, int l, int vw, int NW, int lane) {
    unsigned char* ws = a.ws; const float* modl = (const float*)(ws + WS_MOD) + (size_t)l * 3 * 6144;
    const bf16_t* WinT = (const bf16_t*)(ws + WS_WIN) + (size_t)l * 2304 * 1024; const bf16_t* W1T = (const bf16_t*)(ws + WS_W1) + (size_t)l * 4096 * 1024;
    float* cv1 = (float*)(ws + WS_CV1) + (size_t)l * 3 * 2304; float* cv2 = (float*)(ws + WS_CV2) + (size_t)l * 3 * 4096;
    for (int it = vw; it < 2304 + 4096; it += NW) {
        const bool first = it < 2304; const int n = first ? it : it - 2304; const int N = first ? 2304 : 4096;
        const bf16_t* wrow = (first ? WinT : W1T) + (size_t)n * 1024 + lane * 16; const float* sh = modl + (first ? 0 : 3 * 1024) + lane * 16; float* dst = first ? cv1 : cv2;
        const v4u w0 = *(const v4u*)wrow, w1 = *(const v4u*)(wrow + 8);
        float d[3];
#pragma unroll
        for (int c = 0; c < 3; ++c) { const f32x4 s0 = *(const f32x4*)(sh + c * 6144), s1 = *(const f32x4*)(sh + c * 6144 + 4), s2 = *(const f32x4*)(sh + c * 6144 + 8), s3 = *(const f32x4*)(sh + c * 6144 + 12);
            float t = bflo(w0[0]) * s0[0] + bfhi(w0[0]) * s0[1] + bflo(w0[1]) * s0[2] + bfhi(w0[1]) * s0[3];
            t += bflo(w0[2]) * s1[0] + bfhi(w0[2]) * s1[1] + bflo(w0[3]) * s1[2] + bfhi(w0[3]) * s1[3];
            t += bflo(w1[0]) * s2[0] + bfhi(w1[0]) * s2[1] + bflo(w1[1]) * s2[2] + bfhi(w1[1]) * s2[3];
            t += bflo(w1[2]) * s3[0] + bfhi(w1[2]) * s3[1] + bflo(w1[3]) * s3[2] + bfhi(w1[3]) * s3[3];
            d[c] = wave_sum(t); }
        if (lane == 0) { dst[n] = d[0]; dst[N + n] = d[1]; dst[2 * N + n] = d[2]; }
    }
}
__device__ __forceinline__ void prep_phase(const Args& a, int lane, int wave) {
    unsigned char* ws = a.ws; const float* modl = (const float*)(ws + WS_MOD);
    bf16_t* XN = (bf16_t*)(ws + WS_XN); float* rss = (float*)(ws + WS_RSS1);
    const int gw = blockIdx.x * 8 + wave, NGW = gridDim.x * 8;
    for (int row = gw; row < M; row += NGW) {
        const float* xr = row < MCTX ? a.in[0] + (size_t)row * 1024 : a.in[1] + (size_t)(row - MCTX) * 1024;
        const int cond = row < MCTX ? 0 : 1 + ((row - MCTX) >> 10);
        const float* mp = modl + cond * 6144;
        float s = 0.f;
#pragma unroll
        for (int j = 0; j < 4; ++j) { const int col = 4 * (lane + 64 * j); const f32x4 v = ((const f32x4*)xr)[lane + 64 * j]; s += (v[0] * v[0] + v[1] * v[1]) + (v[2] * v[2] + v[3] * v[3]);
            const f32x4 h = v * (*(const f32x4*)(a.in[8] + col)) * (*(const f32x4*)(mp + 1024 + col) + 1.0f);
            *(v2u*)(XN + (size_t)row * 1024 + col) = (v2u){pk2(h[0], h[1]), pk2(h[2], h[3])}; }
        s = wave_sum(s);
        if (lane < 16) rss[(size_t)row * 16 + lane] = lane == 0 ? s : 0.f;
    }
    cvec_layer(a, 0, gw, NGW, lane);
}

__device__ __forceinline__ void attn_item(LAS unsigned char* lds, const bf16_t* Z, const bf16_t* KC, const bf16_t* VC, bf16_t* MIXC, const float* ghead,
                                          int l, float lam, float lam_init, bool is_lat, int b, int h, int qb, int tid, int lane, int wave) {
    LAS bf16_t* Ks = (LAS bf16_t*)lds;
    LAS bf16_t* Vt = (LAS bf16_t*)(lds + 256 * 72 * 2);
    const int g = lane >> 4, li = lane & 15;
    const int seq0 = is_lat ? MCTX + b * 1024 : b * 256;
    const int qrow = seq0 + qb * 128 + wave * 16 + li;
    bf16x8 qf[2];
    qf[0] = *(const bf16x8*)(Z + (size_t)qrow * NZ + h * 64 + 8 * g);
    qf[1] = *(const bf16x8*)(Z + (size_t)qrow * NZ + h * 64 + 32 + 8 * g);
    f32x4 O[2][4];
#pragma unroll
    for (int c = 0; c < 2; ++c)
#pragma unroll
        for (int d = 0; d < 4; ++d) O[c][d] = (f32x4){0.f, 0.f, 0.f, 0.f};
    float lsum0 = 0.f, lsum1 = 0.f;
    const int ns = is_lat ? 5 : 1;
    v4u kreg[4], vreg[4];
#define ATT_LOAD(stg) do { const bf16_t* kb_; const bf16_t* vb_; int st_; \
        if (is_lat && (stg) == 0) { const size_t o_ = ((size_t)(b * 4 + l) * 256) * 256 + h * 64; kb_ = KC + o_; vb_ = VC + o_; st_ = 256; } \
        else { const int row_ = is_lat ? seq0 + ((stg) - 1) * 256 : seq0; kb_ = Z + (size_t)row_ * NZ + 256 + h * 64; vb_ = Z + (size_t)row_ * NZ + 512 + h * 64; st_ = NZ; } \
        _Pragma("unroll") for (int i_ = 0; i_ < 4; ++i_) { const int idx_ = tid + 512 * i_; kreg[i_] = *(const v4u*)(kb_ + (size_t)(idx_ >> 3) * st_ + (idx_ & 7) * 8); } \
        _Pragma("unroll") for (int i_ = 0; i_ < 2; ++i_) { const int idx_ = tid + 512 * i_, kp_ = idx_ >> 3, ch_ = idx_ & 7; vreg[2 * i_] = *(const v4u*)(vb_ + (size_t)(2 * kp_) * st_ + ch_ * 8); vreg[2 * i_ + 1] = *(const v4u*)(vb_ + (size_t)(2 * kp_ + 1) * st_ + ch_ * 8); } } while (0)
    ATT_LOAD(0);
#pragma unroll 1
    for (int s = 0; s < ns; ++s) {
#pragma unroll
        for (int i = 0; i < 4; ++i) { const int idx = tid + 512 * i; *(LAS v4u*)(Ks + (idx >> 3) * 72 + (idx & 7) * 8) = kreg[i]; }
#pragma unroll
        for (int i = 0; i < 2; ++i) { const int idx = tid + 512 * i, kp = idx >> 3, ch = idx & 7; const v4u v0 = vreg[2 * i], v1 = vreg[2 * i + 1];
#pragma unroll
            for (int e = 0; e < 4; ++e) { *(LAS unsigned*)(Vt + (ch * 8 + 2 * e) * 264 + 2 * kp) = (v0[e] & 0xffffu) | (v1[e] << 16); *(LAS unsigned*)(Vt + (ch * 8 + 2 * e + 1) * 264 + 2 * kp) = (v0[e] >> 16) | (v1[e] & 0xffff0000u); } }
        __syncthreads();
        if (s + 1 < ns) ATT_LOAD(s + 1);
#pragma unroll 1
        for (int kq = 0; kq < 4; ++kq) {
            const LAS bf16_t* Kq = Ks + kq * 64 * 72; const LAS bf16_t* Vq = Vt + kq * 64;
            f32x4 st[2][4];
#pragma unroll
            for (int kt = 0; kt < 4; ++kt)
#pragma unroll
                for (int c = 0; c < 2; ++c) { const bf16x8 af = *(const LAS bf16x8*)(Kq + (kt * 16 + li) * 72 + c * 32 + 8 * g); st[c][kt] = MFMA16(af, qf[c], ((f32x4){0.f, 0.f, 0.f, 0.f})); }
#pragma unroll
            for (int kt = 0; kt < 4; ++kt)
#pragma unroll
                for (int j = 0; j < 4; ++j) { const float p0 = __builtin_amdgcn_exp2f(st[0][kt][j]), p1 = __builtin_amdgcn_exp2f(st[1][kt][j]); lsum0 += p0; lsum1 += p1; st[0][kt][j] = p0; st[1][kt][j] = p1; }
#pragma unroll
            for (int ks = 0; ks < 2; ++ks) {
                bf16x8 pb[2];
#pragma unroll
                for (int c = 0; c < 2; ++c) { v4u w; w.x = pk2(st[c][2 * ks][0], st[c][2 * ks][1]); w.y = pk2(st[c][2 * ks][2], st[c][2 * ks][3]); w.z = pk2(st[c][2 * ks + 1][0], st[c][2 * ks + 1][1]); w.w = pk2(st[c][2 * ks + 1][2], st[c][2 * ks + 1][3]); pb[c] = __builtin_bit_cast(bf16x8, w); }
#pragma unroll
                for (int dt = 0; dt < 4; ++dt) { const LAS bf16_t* vp = Vq + (dt * 16 + li) * 264 + 32 * ks + 4 * g;
                    const v2u lo = *(const LAS v2u*)vp, hi = *(const LAS v2u*)(vp + 16);
                    const bf16x8 af = __builtin_bit_cast(bf16x8, ((v4u){lo.x, lo.y, hi.x, hi.y}));
                    O[0][dt] = MFMA16(af, pb[0], O[0][dt]); O[1][dt] = MFMA16(af, pb[1], O[1][dt]); }
            }
        }
        __syncthreads();
    }
#undef ATT_LOAD
    lsum0 += __shfl_xor(lsum0, 16); lsum0 += __shfl_xor(lsum0, 32); lsum1 += __shfl_xor(lsum1, 16); lsum1 += __shfl_xor(lsum1, 32);
    const float i0 = __builtin_amdgcn_rcpf(lsum0), i1 = lam * __builtin_amdgcn_rcpf(lsum1);
    float ssq = 0.f;
#pragma unroll
    for (int dt = 0; dt < 4; ++dt) { O[0][dt] = O[0][dt] * i0 - O[1][dt] * i1; ssq += (O[0][dt][0] * O[0][dt][0] + O[0][dt][1] * O[0][dt][1]) + (O[0][dt][2] * O[0][dt][2] + O[0][dt][3] * O[0][dt][3]); }
    ssq += __shfl_xor(ssq, 16); ssq += __shfl_xor(ssq, 32);
    const float rs = rsqrtf(ssq * (1.0f / 64.0f) + 1e-6f) * (1.0f - lam_init);
#pragma unroll
    for (int dt = 0; dt < 4; ++dt) { const f32x4 gh = *(const f32x4*)(ghead + dt * 16 + 4 * g); const f32x4 o = O[0][dt] * rs * gh;
        *(v2u*)(MIXC + (size_t)qrow * 1024 + h * 64 + dt * 16 + 4 * g) = (v2u){pk2(o[0], o[1]), pk2(o[2], o[3])}; }
}

__device__ __forceinline__ void gating_item(LAS unsigned char* lds, const bf16_t* Z, const bf16_t* WSP, bf16_t* MIXC, const float* g_sg, const float* b_sg, const float* b_sp,
                                            int l, int chunk, int tid, int lane, int wave) {
    LAS bf16_t* vnT = (LAS bf16_t*)lds;
    const int r0 = chunk * 128;
    bf16x8 afr[4][4];
    { const int gq_ = lane >> 4, li_ = lane & 15;
#pragma unroll
      for (int g = 0; g < 4; ++g)
#pragma unroll
          for (int ks = 0; ks < 4; ++ks) afr[g][ks] = *(const bf16x8*)(WSP + ((size_t)(l * 4 + g) * 128 + wave * 16 + li_) * 128 + ks * 32 + 8 * gq_); }
    { const int tp = tid >> 3, part = tid & 7;
      const v4u* src0 = (const v4u*)(Z + (size_t)(r0 + 2 * tp) * NZ + 1024 + part * 32); const v4u* src1 = (const v4u*)(Z + (size_t)(r0 + 2 * tp + 1) * NZ + 1024 + part * 32);
      v4u ra[4], rb[4]; float sa = 0.f, sb = 0.f;
#pragma unroll
      for (int i = 0; i < 4; ++i) { ra[i] = src0[i]; rb[i] = src1[i];
#pragma unroll
          for (int e = 0; e < 4; ++e) { sa += bflo(ra[i][e]) + bfhi(ra[i][e]); sb += bflo(rb[i][e]) + bfhi(rb[i][e]); } }
      sa += __shfl_xor(sa, 1); sa += __shfl_xor(sa, 2); sa += __shfl_xor(sa, 4); sb += __shfl_xor(sb, 1); sb += __shfl_xor(sb, 2); sb += __shfl_xor(sb, 4);
      const float ma = sa * (1.0f / 256.0f), mb = sb * (1.0f / 256.0f); float qa = 0.f, qb = 0.f;
#pragma unroll
      for (int i = 0; i < 4; ++i)
#pragma unroll
          for (int e = 0; e < 4; ++e) { const float d0 = bflo(ra[i][e]) - ma, d1 = bfhi(ra[i][e]) - ma, e0 = bflo(rb[i][e]) - mb, e1 = bfhi(rb[i][e]) - mb; qa += d0 * d0 + d1 * d1; qb += e0 * e0 + e1 * e1; }
      qa += __shfl_xor(qa, 1); qa += __shfl_xor(qa, 2); qa += __shfl_xor(qa, 4); qb += __shfl_xor(qb, 1); qb += __shfl_xor(qb, 2); qb += __shfl_xor(qb, 4);
      const float rsa = rsqrtf(qa * (1.0f / 256.0f) + 1e-6f), rsb = rsqrtf(qb * (1.0f / 256.0f) + 1e-6f);
#pragma unroll
      for (int i = 0; i < 4; ++i)
#pragma unroll
          for (int e = 0; e < 4; ++e) { const int ch = part * 32 + i * 8 + 2 * e;
              const float g0 = g_sg[l * 256 + ch], g1 = g_sg[l * 256 + ch + 1], b0 = b_sg[l * 256 + ch], b1 = b_sg[l * 256 + ch + 1];
              *(LAS unsigned*)(vnT + ch * 136 + 2 * tp) = pk2((bflo(ra[i][e]) - ma) * rsa * g0 + b0, (bflo(rb[i][e]) - mb) * rsb * g0 + b0);
              *(LAS unsigned*)(vnT + (ch + 1) * 136 + 2 * tp) = pk2((bfhi(ra[i][e]) - ma) * rsa * g1 + b1, (bfhi(rb[i][e]) - mb) * rsb * g1 + b1); } }
    __syncthreads();
    const int gq = lane >> 4, li = lane & 15, p0 = wave * 16;
#pragma unroll
    for (int g = 0; g < 4; ++g) {
        f32x4 acc[4];
#pragma unroll
        for (int nt = 0; nt < 4; ++nt) acc[nt] = (f32x4){0.f, 0.f, 0.f, 0.f};
#pragma unroll
        for (int ks = 0; ks < 4; ++ks) { const bf16x8 af = afr[g][ks];
#pragma unroll
            for (int nt = 0; nt < 4; ++nt) { const bf16x8 bfr = *(const LAS bf16x8*)(vnT + (g * 64 + nt * 16 + li) * 136 + ks * 32 + 8 * gq); acc[nt] = MFMA16(af, bfr, acc[nt]); } }
#pragma unroll
        for (int nt = 0; nt < 4; ++nt)
#pragma unroll
            for (int j = 0; j < 4; ++j) { const int p = p0 + 4 * gq + j, ch = g * 64 + nt * 16 + li; const float bs = b_sp[(l * 4 + g) * 128 + p];
                const float uu = bf2f(Z[(size_t)(r0 + p) * NZ + 768 + ch]);
                MIXC[(size_t)(r0 + p) * 1024 + 256 + ch] = (bf16_t)f2bf(uu * (acc[nt][j] + bs)); }
    }
    __syncthreads();
}

__device__ __forceinline__ void conv_item(LAS unsigned char* lds, const bf16_t* Z, bf16_t* MIXC, const float* w_dw, const float* b_dw, const float* g_cv, const float* b_cv,
                                          int l, int ci, int tid) {
    LAS bf16_t* hs = (LAS bf16_t*)lds;
    LAS float* ys = (LAS float*)(lds + 49152);
    const int r0 = ci * 64;
    int s0, L; if (r0 < MCTX) { s0 = r0 & ~255; L = 256; } else { s0 = MCTX + ((r0 - MCTX) & ~1023); L = 1024; }
    const int t0 = r0 - s0;
    { v4u av[6], gv[6];
#pragma unroll
      for (int i = 0; i < 6; ++i) { const int idx = tid + 512 * i, rr = idx >> 5, c8 = idx & 31, tt = t0 + rr - 15; av[i] = (v4u){0u, 0u, 0u, 0u}; gv[i] = av[i];
          if (idx < 94 * 32 && tt >= 0 && tt < L) { const bf16_t* p = Z + (size_t)(s0 + tt) * NZ + 1280 + c8 * 8; av[i] = *(const v4u*)p; gv[i] = *(const v4u*)(p + 256); } }
#pragma unroll
      for (int i = 0; i < 6; ++i) { const int idx = tid + 512 * i, rr = idx >> 5, c8 = idx & 31; v4u o;
#pragma unroll
          for (int e = 0; e < 4; ++e) o[e] = pk2(bflo(av[i][e]) * sigmoidf_(bflo(gv[i][e])), bfhi(av[i][e]) * sigmoidf_(bfhi(gv[i][e])));
          if (idx < 94 * 32) *(LAS v4u*)(hs + rr * 256 + c8 * 8) = o; } }
    __syncthreads();
    { const int ch = tid & 255, th = tid >> 8;
      float w[31];
#pragma unroll
      for (int j = 0; j < 31; ++j) w[j] = w_dw[(l * 31 + j) * 256 + ch];
      const float bias = b_dw[l * 256 + ch];
#pragma unroll 1
      for (int blk = 0; blk < 4; ++blk) { const int tb = th * 32 + blk * 8; float acc[8];
#pragma unroll
          for (int o = 0; o < 8; ++o) acc[o] = bias;
#pragma unroll
          for (int i = 0; i < 38; ++i) { const float hv = bf2f(hs[(tb + i) * 256 + ch]);
#pragma unroll
              for (int o = 0; o < 8; ++o) { const int j = i - o; if (j >= 0 && j < 31) acc[o] += hv * w[j]; } }
#pragma unroll
          for (int o = 0; o < 8; ++o) ys[(tb + o) * 256 + ch] = acc[o]; } }
    __syncthreads();
    { const int token = tid >> 3, part = tid & 7; const LAS f32x4* yp = (const LAS f32x4*)(ys + token * 256 + part * 32);
      f32x4 v[8]; float s = 0.f;
#pragma unroll
      for (int i = 0; i < 8; ++i) { v[i] = yp[i]; s += (v[i][0] + v[i][1]) + (v[i][2] + v[i][3]); }
      s += __shfl_xor(s, 1); s += __shfl_xor(s, 2); s += __shfl_xor(s, 4); const float mean = s * (1.0f / 256.0f); float q = 0.f;
#pragma unroll
      for (int i = 0; i < 8; ++i) { v[i] = v[i] - mean; q += (v[i][0] * v[i][0] + v[i][1] * v[i][1]) + (v[i][2] * v[i][2] + v[i][3] * v[i][3]); }
      q += __shfl_xor(q, 1); q += __shfl_xor(q, 2); q += __shfl_xor(q, 4); const float rstd = rsqrtf(q * (1.0f / 256.0f) + 1e-6f);
      bf16_t* op = MIXC + (size_t)(r0 + token) * 1024 + 512 + part * 32;
#pragma unroll
      for (int i = 0; i < 4; ++i) { const int ch = part * 32 + i * 8;
          const f32x4 g0 = *(const f32x4*)(g_cv + l * 256 + ch), g1 = *(const f32x4*)(g_cv + l * 256 + ch + 4), b0 = *(const f32x4*)(b_cv + l * 256 + ch), b1 = *(const f32x4*)(b_cv + l * 256 + ch + 4);
          f32x4 y0 = v[2 * i] * rstd * g0 + b0, y1 = v[2 * i + 1] * rstd * g1 + b1;
#pragma unroll
          for (int e = 0; e < 4; ++e) { y0[e] = y0[e] * sigmoidf_(y0[e]); y1[e] = y1[e] * sigmoidf_(y1[e]); }
          *(v4u*)(op + i * 8) = (v4u){pk2(y0[0], y0[1]), pk2(y0[2], y0[3]), pk2(y1[0], y1[1]), pk2(y1[2], y1[3])}; } }
    __syncthreads();
}

__device__ __forceinline__ void fourier_item(LAS unsigned char* lds, const bf16_t* Z, const bf16_t* T, bf16_t* MIXC, int L, int s0, int g, int rb, int tid, int lane, int wave) {
    LAS bf16_t* yt = (LAS bf16_t*)lds;
    const int gq = lane >> 4, li = lane & 15;
    const int krow = rb * 128 + wave * 16 + li; const int ldt = 2 * L;
    f32x4 acc[4];
#pragma unroll
    for (int nt = 0; nt < 4; ++nt) acc[nt] = (f32x4){0.f, 0.f, 0.f, 0.f};
    const int ns = L >> 8;
    v4u zr[8];
#define FOU_LOAD(stg) do { _Pragma("unroll") for (int i_ = 0; i_ < 2; ++i_) { const int idx_ = tid + 512 * i_, tp_ = idx_ >> 3, part_ = idx_ & 7; \
        const v4u* s0_ = (const v4u*)(Z + (size_t)(s0 + (stg) * 256 + 2 * tp_) * NZ + 1792 + (part_ >> 2) * 256 + g * 64 + (part_ & 3) * 16); const v4u* s1_ = (const v4u*)((const bf16_t*)s0_ + NZ); \
        zr[4 * i_] = s0_[0]; zr[4 * i_ + 1] = s0_[1]; zr[4 * i_ + 2] = s1_[0]; zr[4 * i_ + 3] = s1_[1]; } } while (0)
    FOU_LOAD(0);
#pragma unroll 1
    for (int s = 0; s < ns; ++s) {
#pragma unroll
        for (int i = 0; i < 2; ++i) { const int idx = tid + 512 * i, tp = idx >> 3, part = idx & 7; const v4u a0 = zr[4 * i], a1 = zr[4 * i + 1], b0 = zr[4 * i + 2], b1 = zr[4 * i + 3];
            LAS bf16_t* d = yt + (part * 16) * 264 + 2 * tp;
#pragma unroll
            for (int e = 0; e < 4; ++e) {
                *(LAS unsigned*)(d + (2 * e) * 264) = (a0[e] & 0xffffu) | (b0[e] << 16); *(LAS unsigned*)(d + (2 * e + 1) * 264) = (a0[e] >> 16) | (b0[e] & 0xffff0000u);
                *(LAS unsigned*)(d + (8 + 2 * e) * 264) = (a1[e] & 0xffffu) | (b1[e] << 16); *(LAS unsigned*)(d + (9 + 2 * e) * 264) = (a1[e] >> 16) | (b1[e] & 0xffff0000u); } }
        __syncthreads();
        if (s + 1 < ns) FOU_LOAD(s + 1);
#pragma unroll
        for (int cs = 0; cs < 2; ++cs) {
            bf16x8 af[8];
#pragma unroll
            for (int ks = 0; ks < 8; ++ks) af[ks] = *(const bf16x8*)(T + (size_t)krow * ldt + cs * L + s * 256 + ks * 32 + 8 * gq);
#pragma unroll
            for (int ks = 0; ks < 8; ++ks)
#pragma unroll
                for (int nt = 0; nt < 4; ++nt) { const bf16x8 bfr = *(const LAS bf16x8*)(yt + (cs * 64 + nt * 16 + li) * 264 + ks * 32 + 8 * gq); acc[nt] = MFMA16(af[ks], bfr, acc[nt]); }
        }
        __syncthreads();
    }
#undef FOU_LOAD
#pragma unroll
    for (int nt = 0; nt < 4; ++nt)
#pragma unroll
        for (int j = 0; j < 4; ++j) MIXC[(size_t)(s0 + rb * 128 + wave * 16 + 4 * gq + j) * 1024 + 768 + g * 64 + nt * 16 + li] = (bf16_t)f2bf(acc[nt][j]);
}

#ifndef MIXMASK
#define MIXMASK 15
#endif
__device__ __forceinline__ void mix_phase(const Args& a, LAS unsigned char* lds, const int l, const int tid_outer, int, int) {
    unsigned char* ws = a.ws;
    const bf16_t* Z = (const bf16_t*)(ws + WS_Z); bf16_t* MIXC = (bf16_t*)(ws + WS_MIXC);
    float d1 = 0.f, d2 = 0.f;
    for (int i = 0; i < 32; ++i) { d1 += a.in[13][l * 32 + i] * a.in[14][l * 32 + i]; d2 += a.in[15][l * 32 + i] * a.in[16][l * 32 + i]; }
    const float lam_init = 0.8f - 0.6f * __expf(-0.3f * (float)l);
    const float lam = __expf(d1) - __expf(d2) + lam_init;
    const int l_outer = l;
    unsigned* qctr = (unsigned*)(ws + WS_BAR) + 3584 + 64 * l;
    LAS int* qslot = (LAS int*)(lds + 131072 + 64);
    for (;;) {
        if (tid_outer == 0) *qslot = (int)__hip_atomic_fetch_add(qctr, 1u, __ATOMIC_RELAXED, __HIP_MEMORY_SCOPE_AGENT);
        __syncthreads();
        const int it = *qslot;
        __syncthreads();
        if (it >= 880) break;
        int tid = tid_outer; asm volatile("" : "+v"(tid));
        const int lane = tid & 63, wave = __builtin_amdgcn_readfirstlane(tid >> 6);
        int l = l_outer; asm volatile("" : "+s"(l));
        if (it < 64) { if ((MIXMASK & 1) && !(MIXMASK & 16)) attn_item(lds, Z, (const bf16_t*)(ws + WS_KC), (const bf16_t*)(ws + WS_VC), MIXC, a.in[17] + l * 64, l, lam, lam_init, true, it >> 5, (it >> 3) & 3, it & 7, tid, lane, wave); }
        else if (it < 128) { const int r = it - 64; if (MIXMASK & 2) fourier_item(lds, Z, (const bf16_t*)(ws + WS_T1024), MIXC, 1024, MCTX + (r >> 5) * 1024, (r >> 3) & 3, r & 7, tid, lane, wave); }
        else if (it < 208) { if (MIXMASK & 4) gating_item(lds, Z, (const bf16_t*)(ws + WS_WSP), MIXC, a.in[18], a.in[19], a.in[21], l, it - 128, tid, lane, wave); }
        else if (it < 368) { if (MIXMASK & 8) conv_item(lds, Z, MIXC, a.in[22], a.in[23], a.in[24], a.in[25], l, it - 208, tid); }
        else if (it < 624) { const int r = it - 368; if ((MIXMASK & 1) && !(MIXMASK & 32)) attn_item(lds, Z, (const bf16_t*)(ws + WS_KC), (const bf16_t*)(ws + WS_VC), MIXC, a.in[17] + l * 64, l, lam, lam_init, false, r >> 3, (r >> 1) & 3, r & 1, tid, lane, wave); }
        else { const int r = it - 624; if (MIXMASK & 2) fourier_item(lds, Z, (const bf16_t*)(ws + WS_T256), MIXC, 256, (r >> 3) * 256, (r >> 1) & 3, r & 1, tid, lane, wave); }
    }
}

constexpr int N_PHASES = 1 + 7 * NL;
#ifndef REPEAT_KIND
#define REPEAT_KIND -1
#endif
#ifndef PHASE_MASK
#define PHASE_MASK 255
#endif
__global__ void __launch_bounds__(512, 2) fwd_megakernel(Args a) {
    extern __shared__ __attribute__((aligned(16))) unsigned char lds_raw[];
    LAS unsigned char* lds = (LAS unsigned char*)lds_raw;
    unsigned char* ws = a.ws;
    const bool coop = (a.ph_hi - a.ph_lo) > 1;
    XcdBarrier bar; bar.bar = (unsigned*)(ws + WS_BAR); bar.x = 0; bar.st = nullptr;
    if (coop) {
        if (threadIdx.x < 64) ((LAS unsigned*)(lds + 131072))[threadIdx.x] = 0u;
        __syncthreads();
        bar = xcd_barrier_post((unsigned*)(ws + WS_BAR), (volatile LAS unsigned*)(lds + 131072));
        if (a.ph_hi > 100000) cg::this_grid().sync();
    }
    const float* mod = (const float*)(ws + WS_MOD);
    bf16_t* XN = (bf16_t*)(ws + WS_XN); bf16_t* Zb = (bf16_t*)(ws + WS_Z); bf16_t* MIXC = (bf16_t*)(ws + WS_MIXC); bf16_t* HB = (bf16_t*)(ws + WS_HB);
    float* X1 = (float*)(ws + WS_X1); float* X = (float*)(ws + WS_X);
#if REPEAT_KIND >= 0
    const int nsteps = N_PHASES + (REPEAT_KIND == 7 ? 1 : NL);
    for (int step = 0; step < nsteps; ++step) {
        int ph;
        if (REPEAT_KIND == 7) ph = step == 0 ? 0 : step - 1;
        else if (step == 0) ph = 0;
        else { const int s_ = step - 1, l_ = s_ / 8, j_ = s_ % 8; ph = 1 + 7 * l_ + (j_ <= REPEAT_KIND ? j_ : j_ - 1); }
        const bool last_step = step + 1 >= nsteps;
#else
    for (int ph = a.ph_lo; ph < a.ph_hi; ++ph) {
        const bool last_step = ph + 1 >= a.ph_hi;
#endif
        int tid_raw = threadIdx.x; asm volatile("" : "+v"(tid_raw));
        const int tid = tid_raw, lane = tid & 63, wave = __builtin_amdgcn_readfirstlane(tid >> 6);
        if (ph == 0) { if (PHASE_MASK & 128) p0_prologue(a, lds, tid, lane, wave); }
        else {
            const int l = (ph - 1) / 7, k = (ph - 1) % 7;
            const float* modl = mod + (size_t)l * 3 * 6144;
            const float* xin0 = l == 0 ? a.in[0] : X; const float* xin1 = l == 0 ? a.in[1] : X + (size_t)MCTX * 1024;
            if (k == 4 || (k == 0 && l > 0)) continue;
            if (k == 0) { prep_phase(a, lane, wave); }
            else if (k == 1) { if (PHASE_MASK & 2) {
                pg8::Gemm g{XN, (const bf16_t*)(ws + WS_WIN) + (size_t)l * 2304 * 1024, M, NZ, DM}; pg8::StaticOrder S; S.init(M, NZ, gridDim.x, blockIdx.x);
                pg8::EpiG1 E{Zb, a.out + (size_t)M * 1024, a.out + (size_t)M * 1024 + (size_t)32 * 4 * 256 * 256, a.in[11] + l * 32, a.in[12] + l * 32, (const float*)(ws + WS_ROPE), l, (const float*)(ws + WS_RSS1), (const float*)(ws + WS_CV1) + (size_t)l * 3 * 2304, (const LAS float*)(lds + pg8::RSS_LDS_OFF)};
                pg8::gemm_phase<pg8::EpiG1, pg8::StaticOrder, true, true>(lds, g, S, E); }
            }
            else if (k == 2) { if (PHASE_MASK & 4) mix_phase(a, lds, l, tid, lane, wave); }
            else if (k == 3) { if (PHASE_MASK & 8) {
                pg8::Gemm g{MIXC, (const bf16_t*)(ws + WS_WOUT) + (size_t)l * 1024 * 1024, M, DM, DM}; pg8::StaticOrder S; S.init(M, DM, gridDim.x, blockIdx.x); S.wgm = 5;
                pg8::EpiRes E{a.in[0], a.in[1], l == 0 ? nullptr : (const bf16_t*)X, nullptr, (bf16_t*)X1, modl + 2 * 1024, XN, a.in[9] + l * 1024, modl + 4 * 1024, (float*)(ws + WS_RSS2)};
                pg8::gemm_phase<pg8::EpiRes, pg8::StaticOrder, true, true>(lds, g, S, E);
                if (l + 1 < NL && (int)blockIdx.x >= 160 && (int)gridDim.x > 160) weights_layer(a, lds, l + 1, blockIdx.x - 160, gridDim.x - 160, tid, lane, wave); }
            }
            else if (k == 4) { if (PHASE_MASK & 1) norm_phase(X1, X1 + (size_t)MCTX * 1024, a.in[9] + l * 1024, modl, 3, 4, XN, lane, wave); }
            else if (k == 5) { if (PHASE_MASK & 16) {
                pg8::Gemm g{XN, (const bf16_t*)(ws + WS_W1) + (size_t)l * 4096 * 1024, M, FF, DM}; pg8::StaticOrder S; S.init(M, FF, gridDim.x, blockIdx.x);
                pg8::EpiRelu2 E{HB, FF, (const float*)(ws + WS_RSS2), (const float*)(ws + WS_CV2) + (size_t)l * 3 * 4096, (const LAS float*)(lds + pg8::RSS_LDS_OFF)};
                pg8::gemm_phase<pg8::EpiRelu2, pg8::StaticOrder, true, true>(lds, g, S, E);
 }
            }
            else { if (PHASE_MASK & 32) {
                pg8::Gemm g{HB, (const bf16_t*)(ws + WS_W2) + (size_t)l * 1024 * 4096, M, DM, FF}; pg8::StaticOrder S; S.init(M, DM, gridDim.x, blockIdx.x); S.wgm = 5;
                pg8::EpiRes E{nullptr, nullptr, (const bf16_t*)X1, l == NL - 1 ? a.out : nullptr, l == NL - 1 ? nullptr : (bf16_t*)X, modl + 5 * 1024, l == NL - 1 ? nullptr : XN, a.in[8] + (l + 1 < NL ? l + 1 : l) * 1024, modl + 3 * 6144 + 1 * 1024, (float*)(ws + WS_RSS1)};
                pg8::gemm_phase<pg8::EpiRes, pg8::StaticOrder, true, true>(lds, g, S, E);
                if (l + 1 < NL && (int)blockIdx.x >= 160) cvec_layer(a, l + 1, (blockIdx.x - 160) * 8 + wave, (gridDim.x - 160) * 8, lane); }
            }
        }
        if (!last_step) { xcd_barrier(bar); }
    }
}

#ifndef MK_MULTI
#define MK_MULTI 0
#endif
extern "C" void kernel_launch(void* const* d_in, const int* in_sizes, int n_in, void* d_out, int out_size, void* d_ws, size_t ws_size, hipStream_t stream) {
    static int grid = 0;
    if (grid == 0) {
        if (n_in != 29 || ws_size < WS_END || out_size != 27262976) { fprintf(stderr, "kernel_launch: unexpected shapes: n_in %d ws %zu (need %zu) out %d\n", n_in, ws_size, (size_t)WS_END, out_size); grid = -1; return; }
        int dev = 0, cus = 0, per_cu = 0;
        if (hipGetDevice(&dev) != hipSuccess || hipDeviceGetAttribute(&cus, hipDeviceAttributeMultiprocessorCount, dev) != hipSuccess) { grid = -1; return; }
        if (hipFuncSetAttribute((const void*)fwd_megakernel, hipFuncAttributeMaxDynamicSharedMemorySize, LDS_BYTES) != hipSuccess) { fprintf(stderr, "kernel_launch: hipFuncSetAttribute failed\n"); grid = -1; return; }
        if (hipOccupancyMaxActiveBlocksPerMultiprocessor(&per_cu, (const void*)fwd_megakernel, 512, LDS_BYTES) != hipSuccess || per_cu < 1) { fprintf(stderr, "kernel_launch: occupancy query gave %d\n", per_cu); per_cu = 1; }
        (void)hipGetLastError();
        grid = cus * per_cu;
    }
    if (grid < 0) return;
    (void)hipMemsetAsync((char*)d_ws + WS_BAR, 0, WS_MOD + MOD_BYTES, stream);
    Args a{};
    for (int i = 0; i < 29; ++i) a.in[i] = (const float*)d_in[i];
    a.out = (float*)d_out; a.ws = (unsigned char*)d_ws;
#if MK_MULTI
    for (int ph = 0; ph < N_PHASES; ++ph) { a.ph_lo = ph; a.ph_hi = ph + 1; hipLaunchKernelGGL(fwd_megakernel, dim3(grid), dim3(512), LDS_BYTES, stream, a); }
#else
    a.ph_lo = 0; a.ph_hi = N_PHASES;
    void* args[] = {&a};
    hipError_t e = hipLaunchCooperativeKernel((const void*)fwd_megakernel, dim3(grid), dim3(512), args, LDS_BYTES, stream);
    if (e != hipSuccess) fprintf(stderr, "cooperative launch failed: %s (grid %d)\n", hipGetErrorString(e), grid);
#endif
}
```

```cpp
#include <hip/hip_runtime.h>
#include <hip/hip_cooperative_groups.h>
#include <cstdio>
#include <cstdint>
namespace cg = cooperative_groups;
namespace pg8 {
#define PG8_LAS __attribute__((address_space(3)))
typedef unsigned short bf16_t;
typedef short bf16x8 __attribute__((ext_vector_type(8)));
typedef float f32x4 __attribute__((ext_vector_type(4)));
typedef unsigned u32x4 __attribute__((ext_vector_type(4)));
constexpr int RSS_LDS_OFF = 131072 + 256;
constexpr int BM = 256, BK = 64, HALF = 128, HTB = HALF * BK * 2  , STAGE_BYTES = 8 * HTB, NXCD = 8, WGM = 8;

__host__ __device__ __forceinline__ int lds_byte(int r, int c) { const int st = (r >> 4) * 2 + (c >> 5), rr = r & 15, cc = c & 31, ob = rr * 64 + cc * 2; return st * 1024 + (ob ^ (((ob >> 9) & 1) << 5)); }
__host__ __device__ __forceinline__ void stage_rc(int b, int& R, int& C) { const int st = b / 1024, sb = b % 1024, swz = sb ^ (((sb >> 9) & 1) << 5); R = (st >> 1) * 16 + swz / 64; C = (st & 1) * 32 + (swz % 64) / 2; }
__host__ __device__ __forceinline__ int perm32(int rho) { const int n = rho >> 4, i = rho & 15; return 8 * (i >> 2) + 4 * n + (i & 3); }

struct Unit { int pm, pn; };
struct Gemm { const bf16_t* A; const bf16_t* Bt; int M, N, K; };

struct StaticOrder {
    int nM, nN, nwg, G, c;
    __host__ __device__ void init(int M, int N, int G_, int c_) { nM = M / BM; nN = N / BM; nwg = nM * nN; G = G_; c = c_; }
    __host__ __device__ bool next(int i, Unit& u) const {
        const long L = (long)i * G + c; if (L >= nwg) return false;
        int wgid = (int)L; { const int q = nwg / NXCD, r = nwg % NXCD, xcd = wgid % NXCD, off = wgid / NXCD; wgid = (xcd < r ? xcd * (q + 1) : r * (q + 1) + (xcd - r) * q) + off; }
        const int nig = WGM * nN, gid = wgid / nig, fm = gid * WGM, gsz = (nM - fm) < WGM ? (nM - fm) : WGM;
        u.pm = fm + ((wgid % nig) % gsz); u.pn = (wgid % nig) / gsz; return true;
    }
    __device__ __forceinline__ void a_ready(const Unit&) const {}
    __device__ __forceinline__ void done(const Unit&) const {}
};

typedef __bf16 bf16v2_t __attribute__((ext_vector_type(2)));
typedef float f32v2_t __attribute__((ext_vector_type(2)));
__device__ __forceinline__ unsigned cvt_pk_bf16(float lo, float hi) { const bf16v2_t r = __builtin_convertvector((f32v2_t){lo, hi}, bf16v2_t); return __builtin_bit_cast(unsigned, r); }
typedef float f32x2 __attribute__((ext_vector_type(2)));
__device__ __forceinline__ float dot4(const f32x4 a) { return (a[0] * a[0] + a[1] * a[1]) + (a[2] * a[2] + a[3] * a[3]); }
__device__ __forceinline__ f32x4 shfl_xor4(const f32x4 v, int m) { f32x4 r; r[0] = __shfl_xor(v[0], m); r[1] = __shfl_xor(v[1], m); r[2] = __shfl_xor(v[2], m); r[3] = __shfl_xor(v[3], m); return r; }
__device__ __forceinline__ float gelu_tanh(float x) { const float u = 0.7978845608028654f * (x + 0.044715f * x * x * x); return x * __builtin_amdgcn_rcpf(1.0f + __expf(-2.0f * u)); }
__device__ __forceinline__ f32x4 gelu4(const f32x4 v) { f32x4 r; r[0] = gelu_tanh(v[0]); r[1] = gelu_tanh(v[1]); r[2] = gelu_tanh(v[2]); r[3] = gelu_tanh(v[3]); return r; }
__device__ __forceinline__ u32x4 pack8(const f32x4 v0, const f32x4 v1) { u32x4 w; w.x = cvt_pk_bf16(v0[0], v0[1]); w.y = cvt_pk_bf16(v0[2], v0[3]); w.z = cvt_pk_bf16(v1[0], v1[1]); w.w = cvt_pk_bf16(v1[2], v1[3]); return w; }

__device__ __forceinline__ float rinv_lds(const PG8_LAS float* rss_lds, int ai, int wr, int m, int fr, int fq) {
    const f32x4 s4 = ((const PG8_LAS f32x4*)rss_lds)[(ai * HALF + wr * 64 + m * 16 + fr) * 4 + fq]; float sr = (s4[0] + s4[1]) + (s4[2] + s4[3]); sr += __shfl_xor(sr, 16); sr += __shfl_xor(sr, 32); return rsqrtf(sr * (1.0f / 1024.0f) + 1e-6f); }
struct EpiG1 {
    static constexpr bool PERM = true, AFTER_DRAIN = false, NEEDS_RSS = true;
    bf16_t* Z; float* outk; float* outv; const float* gq; const float* gk; const float* rope; int layer;
    const float* rss; const float* cvec; const PG8_LAS float* rss_lds;
    __device__ __forceinline__ void operator()(const f32x4 (&acc)[2][2][4][2], const Unit& u, int wr, int wc, int fr, int fq) const {
        const int pn = u.pn, pm = u.pm;
        const int row0 = pm * BM + wr * 64 + fr;
        const bool latent = pm >= 32;
        const int colw = wc * 32 + 8 * fq;
        f32x4 cb[2][2];
        { const float* cp = cvec + (pm < 32 ? 0 : 1 + ((pm - 32) >> 2)) * 2304 + pn * 256 + colw;
#pragma unroll
          for (int bj = 0; bj < 2; ++bj) { cb[bj][0] = *(const f32x4*)(cp + bj * HALF); cb[bj][1] = *(const f32x4*)(cp + bj * HALF + 4); } }
        if (pn <= 1) {
            const float* gsrc = pn == 0 ? gq : gk;
            const f32x4 g0 = *(const f32x4*)(gsrc + 8 * fq), g1 = *(const f32x4*)(gsrc + 8 * fq + 4);
            const float qscale = pn == 0 ? (0.17677669529663687f * 1.4426950408889634f) : 1.0f;
            const float sgn = (fq & 1) ? 1.0f : -1.0f;
#pragma unroll
            for (int ai = 0; ai < 2; ++ai)
#pragma unroll
                for (int m = 0; m < 4; ++m) {
                    const int r = row0 + ai * HALF + m * 16; const float rv = rinv_lds(rss_lds, ai, wr, m, fr, fq);
                    f32x4 c0 = {1.f, 1.f, 1.f, 1.f}, c1 = c0, s0 = {0.f, 0.f, 0.f, 0.f}, s1 = s0;
                    if (latent) { const int t = (r - 8192) & 1023; const int pos = (fq >> 1) ? (t & 63) : (t >> 6); const float* rp = rope + pos * 16;
                        c0 = *(const f32x4*)(rp); c1 = *(const f32x4*)(rp + 4); s0 = *(const f32x4*)(rp + 8); s1 = *(const f32x4*)(rp + 12); }
#pragma unroll
                    for (int bj = 0; bj < 2; ++bj) {
                        f32x4 v0 = acc[ai][bj][m][0] * rv + cb[bj][0], v1 = acc[ai][bj][m][1] * rv + cb[bj][1];
                        float ss = dot4(v0) + dot4(v1);
                        ss += __shfl_xor(ss, 16); ss += __shfl_xor(ss, 32);
                        const float rinv = rsqrtf(ss * (1.0f / 32.0f) + 1e-6f);
                        v0 = v0 * rinv * g0; v1 = v1 * rinv * g1;
                        if (pn == 1 && !latent) { float* o = outk + ((size_t)((r >> 8) * 4 + layer) * 256 + (r & 255)) * 256 + bj * HALF + colw; *(f32x4*)o = v0; *(f32x4*)(o + 4) = v1; }
                        if (latent) { const f32x4 p0 = shfl_xor4(v0, 16), p1 = shfl_xor4(v1, 16); v0 = v0 * c0 + (p0 * s0) * sgn; v1 = v1 * c1 + (p1 * s1) * sgn; }
                        v0 = v0 * qscale; v1 = v1 * qscale;
                        *(u32x4*)(Z + (size_t)r * 2304 + pn * 256 + bj * HALF + colw) = pack8(v0, v1);
                    }
                }
        } else {
#pragma unroll
            for (int ai = 0; ai < 2; ++ai)
#pragma unroll
                for (int m = 0; m < 4; ++m) {
                    const int r = row0 + ai * HALF + m * 16; const float rv = rinv_lds(rss_lds, ai, wr, m, fr, fq);
#pragma unroll
                    for (int bj = 0; bj < 2; ++bj) {
                        f32x4 v0 = acc[ai][bj][m][0] * rv + cb[bj][0], v1 = acc[ai][bj][m][1] * rv + cb[bj][1];
                        if (pn == 2 && !latent) { float* o = outv + ((size_t)((r >> 8) * 4 + layer) * 256 + (r & 255)) * 256 + bj * HALF + colw; *(f32x4*)o = v0; *(f32x4*)(o + 4) = v1; }
                        if (pn == 3 || pn == 4) { v0 = gelu4(v0); v1 = gelu4(v1); }
                        *(u32x4*)(Z + (size_t)r * 2304 + pn * 256 + bj * HALF + colw) = pack8(v0, v1);
                    }
                }
        }
    }
};
struct EpiRes {
    static constexpr bool PERM = true, AFTER_DRAIN = false, NEEDS_RSS = false;
    const float* base0; const float* base1;
    const bf16_t* baseh;
    float* outf; bf16_t* outh;
    const float* gate;
    bf16_t* an; const float* gnorm; const float* scv; float* rss_out;
    __device__ __forceinline__ void operator()(const f32x4 (&acc)[2][2][4][2], const Unit& u, int wr, int wc, int fr, int fq) const {
        const int pm = u.pm; const int cond = pm < 32 ? 0 : 1 + ((pm - 32) >> 2);
        const int col0 = u.pn * BM + wc * 32 + 8 * fq;
        const float* gp = gate + cond * 6144 + col0;
        f32x4 gv[2][2];
#pragma unroll
        for (int bj = 0; bj < 2; ++bj)
#pragma unroll
            for (int n = 0; n < 2; ++n) gv[bj][n] = *(const f32x4*)(gp + bj * HALF + n * 4);
        const size_t rowbase = (size_t)(pm * BM) * 1024;
        const float* bs = pm < 32 ? base0 + rowbase : base1 + (rowbase - (size_t)8192 * 1024);
        f32x4 gs[2][2];
        if (an) {
#pragma unroll
            for (int bj = 0; bj < 2; ++bj)
#pragma unroll
                for (int n = 0; n < 2; ++n) gs[bj][n] = *(const f32x4*)(gnorm + col0 + bj * HALF + n * 4) * (*(const f32x4*)(scv + cond * 6144 + col0 + bj * HALF + n * 4) + 1.0f);
        }
#pragma unroll
        for (int ai = 0; ai < 2; ++ai)
#pragma unroll
            for (int m = 0; m < 4; ++m) { const size_t off = (size_t)(ai * HALF + wr * 64 + m * 16 + fr) * 1024 + col0; float ssq = 0.f;
#pragma unroll
                for (int bj = 0; bj < 2; ++bj) { const size_t o2 = off + bj * HALF; f32x4 b0, b1;
                    if (baseh) { const u32x4 w = *(const u32x4*)(baseh + rowbase + o2);
                        b0 = (f32x4){__uint_as_float(w.x << 16), __uint_as_float(w.x & 0xffff0000u), __uint_as_float(w.y << 16), __uint_as_float(w.y & 0xffff0000u)};
                        b1 = (f32x4){__uint_as_float(w.z << 16), __uint_as_float(w.z & 0xffff0000u), __uint_as_float(w.w << 16), __uint_as_float(w.w & 0xffff0000u)}; }
                    else { b0 = *(const f32x4*)(bs + o2); b1 = *(const f32x4*)(bs + o2 + 4); }
                    const f32x4 x0 = b0 + gv[bj][0] * acc[ai][bj][m][0], x1 = b1 + gv[bj][1] * acc[ai][bj][m][1];
                    if (outh) *(u32x4*)(outh + rowbase + o2) = pack8(x0, x1); else { *(f32x4*)(outf + rowbase + o2) = x0; *(f32x4*)(outf + rowbase + o2 + 4) = x1; }
                    if (an) { ssq += dot4(x0) + dot4(x1); *(u32x4*)(an + rowbase + o2) = pack8(x0 * gs[bj][0], x1 * gs[bj][1]); } }
                if (an) { ssq += __shfl_xor(ssq, 16); ssq += __shfl_xor(ssq, 32); if (fq == 0) rss_out[(size_t)(pm * BM + ai * HALF + wr * 64 + m * 16 + fr) * 16 + u.pn * 4 + wc] = ssq; } }
    }
};
struct EpiRelu2 {
    static constexpr bool PERM = true, AFTER_DRAIN = false, NEEDS_RSS = true;
    bf16_t* O; int ldc; const float* rss; const float* cvec; const PG8_LAS float* rss_lds;
    __device__ __forceinline__ void operator()(const f32x4 (&acc)[2][2][4][2], const Unit& u, int wr, int wc, int fr, int fq) const {
        const int row0 = u.pm * BM + wr * 64 + fr; const int col0 = u.pn * BM + wc * 32 + 8 * fq;
        f32x4 cb[2][2];
        { const float* cp = cvec + (u.pm < 32 ? 0 : 1 + ((u.pm - 32) >> 2)) * ldc + col0;
#pragma unroll
          for (int bj = 0; bj < 2; ++bj) { cb[bj][0] = *(const f32x4*)(cp + bj * HALF); cb[bj][1] = *(const f32x4*)(cp + bj * HALF + 4); } }
#pragma unroll
        for (int ai = 0; ai < 2; ++ai)
#pragma unroll
            for (int m = 0; m < 4; ++m) { bf16_t* rowp = O + (size_t)(row0 + ai * HALF + m * 16) * ldc + col0; const float rv = rinv_lds(rss_lds, ai, wr, m, fr, fq);
#pragma unroll
                for (int bj = 0; bj < 2; ++bj) { f32x4 v0 = acc[ai][bj][m][0] * rv + cb[bj][0], v1 = acc[ai][bj][m][1] * rv + cb[bj][1];
                    v0 = __builtin_elementwise_max(v0, (f32x4){0.f, 0.f, 0.f, 0.f}); v1 = __builtin_elementwise_max(v1, (f32x4){0.f, 0.f, 0.f, 0.f});
                    v0 = v0 * v0; v1 = v1 * v1; *(u32x4*)(rowp + bj * HALF) = pack8(v0, v1); } }
    }
};

template <class Epi, class Sched, bool ALIGN_EPI = false, bool SP2 = false>
__device__ __forceinline__ void gemm_phase(PG8_LAS unsigned char* lds, const Gemm g, const Sched& S, const Epi& E) {
    int tid_raw = threadIdx.x; asm volatile("" : "+v"(tid_raw));
    const int tid = tid_raw, wid = __builtin_amdgcn_readfirstlane(tid >> 6), lane = tid & 63, wr = wid >> 2, wc = wid & 3, fr = lane & 15, fq = lane >> 4;
    const int K = g.K, nt = K / BK;
    unsigned voffA[2], voffB[2];
#pragma unroll
    for (int i = 0; i < 2; ++i) { int R, C; stage_rc(tid * 16 + i * 8192, R, C); const int Rb = Epi::PERM ? ((R & ~31) + perm32(R & 31)) : R;
        voffA[i] = (unsigned)(R * K + C) * 2u; voffB[i] = (unsigned)(Rb * K + C) * 2u; }
    const size_t kstep = (size_t)(BK * 2);
    const size_t hstep = (size_t)HALF * K * 2;
    const size_t tstep = 2 * hstep;
    const unsigned ldsw = (unsigned)wid * 1024u;
    const int aoff = lds_byte(wr * 64 + fr, fq * 8), boff = lds_byte(wc * 32 + fr, fq * 8);
#define PG8_SA(b, h) (((b) * 2 + (h)) * HTB)
#define PG8_SB(b, h) ((4 + (b) * 2 + (h)) * HTB)
#define PG8_STAGE(bufoff, gbase, voff) do { _Pragma("unroll") for (int _i = 0; _i < 2; ++_i) \
        __builtin_amdgcn_global_load_lds((const unsigned*)((const char*)(gbase) + (voff)[_i]), (PG8_LAS unsigned*)(lds + (bufoff) + ldsw + _i * 8192), 16, 0, 0); } while (0)
#define PG8_LDA(dst, b, h) do { _Pragma("unroll") for (int m = 0; m < 4; ++m) _Pragma("unroll") for (int k = 0; k < 2; ++k) dst[m][k] = *(const PG8_LAS bf16x8*)(lds + PG8_SA(b, h) + aoff + m * 2048 + k * 1024); } while (0)
#define PG8_LDB(dst, b, h) do { _Pragma("unroll") for (int n = 0; n < 2; ++n) _Pragma("unroll") for (int k = 0; k < 2; ++k) dst[n][k] = *(const PG8_LAS bf16x8*)(lds + PG8_SB(b, h) + boff + n * 2048 + k * 1024); } while (0)
#define PG8_MMA(ai, bj, At, Bt) do { __builtin_amdgcn_s_setprio(1); _Pragma("unroll") for (int m = 0; m < 4; ++m) _Pragma("unroll") for (int n = 0; n < 2; ++n) _Pragma("unroll") for (int k = 0; k < 2; ++k) \
        acc[ai][bj][m][n] = __builtin_amdgcn_mfma_f32_16x16x32_bf16(Bt[n][k], At[m][k], acc[ai][bj][m][n], 0, 0, 0); __builtin_amdgcn_s_setprio(0); } while (0)
#define PG8_WAIT_V(n) asm volatile("s_waitcnt vmcnt(" #n ")" ::: "memory")
#define PG8_WAIT_L(n) asm volatile("s_waitcnt lgkmcnt(" #n ")" ::: "memory")
#define PG8_BAR __builtin_amdgcn_s_barrier()
#define PG8_SCHED __builtin_amdgcn_sched_barrier(0)
    Unit cur, nxt; int ui = 0;
    if (!S.next(0, cur)) return;
#define PG8_RSS_DMA(unit) do { const char* rsrc_ = (const char*)E.rss + (size_t)(unit).pm * (BM * 64) + (size_t)tid * 16; \
        _Pragma("unroll") for (int _i = 0; _i < 2; ++_i) __builtin_amdgcn_global_load_lds((const unsigned*)(rsrc_ + _i * 8192), (PG8_LAS unsigned*)(lds + RSS_LDS_OFF + ldsw + _i * 8192), 16, 0, 0); } while (0)
    if constexpr (Epi::NEEDS_RSS) { static_assert(ALIGN_EPI, "the row-statistics panel hand-over relies on the aligned epilogues"); PG8_RSS_DMA(cur); }
    f32x4 acc[2][2][4][2];
#pragma unroll
    for (int a = 0; a < 2; ++a)
#pragma unroll
        for (int b = 0; b < 2; ++b)
#pragma unroll
            for (int m = 0; m < 4; ++m)
#pragma unroll
                for (int n = 0; n < 2; ++n) acc[a][b][m][n] = (f32x4){0.f, 0.f, 0.f, 0.f};
    bf16x8 At[4][2], B0[2][2], B1[2][2];
    const char* cA = (const char*)g.A + (size_t)cur.pm * tstep; const char* cB = (const char*)g.Bt + (size_t)cur.pn * tstep;
    S.a_ready(cur);
    if constexpr (SP2) {
        PG8_STAGE(PG8_SB(0, 0), cB, voffB); PG8_STAGE(PG8_SB(0, 1), cB + hstep, voffB); PG8_STAGE(PG8_SA(0, 0), cA, voffA); PG8_STAGE(PG8_SA(0, 1), cA + hstep, voffA);
        if (wr == 1) PG8_BAR;
        PG8_WAIT_V(2); PG8_BAR;
        PG8_STAGE(PG8_SB(1, 0), cB + kstep, voffB); PG8_STAGE(PG8_SA(1, 0), cA + kstep, voffA); PG8_STAGE(PG8_SB(1, 1), cB + hstep + kstep, voffB);
        PG8_WAIT_V(6); PG8_BAR;
    } else {
        PG8_STAGE(PG8_SB(0, 0), cB, voffB); PG8_STAGE(PG8_SA(0, 0), cA, voffA); PG8_STAGE(PG8_SB(0, 1), cB + hstep, voffB); PG8_STAGE(PG8_SA(0, 1), cA + hstep, voffA);
        if (wr == 1) PG8_BAR;
        PG8_WAIT_V(4); PG8_BAR;
        PG8_STAGE(PG8_SB(1, 0), cB + kstep, voffB); PG8_STAGE(PG8_SA(1, 0), cA + kstep, voffA); PG8_STAGE(PG8_SB(1, 1), cB + hstep + kstep, voffB);
        PG8_WAIT_V(6); PG8_BAR;
    }
    for (;;) {
        const bool has_next = S.next(ui + 1, nxt);
        const char* nA = has_next ? (const char*)g.A + (size_t)nxt.pm * tstep : cA; const char* nB = has_next ? (const char*)g.Bt + (size_t)nxt.pn * tstep : cB;
        for (int t = 0; t < nt; t += 2) {
            const bool last = (t == nt - 2);
            const char* a1 = cA + (size_t)(t + 1) * kstep;
            const char* a2 = last ? nA : cA + (size_t)(t + 2) * kstep; const char* b2 = last ? nB : cB + (size_t)(t + 2) * kstep;
            const char* a3 = a2 + kstep; const char* b3 = b2 + kstep;
            if (last && has_next) S.a_ready(nxt);
            if constexpr (SP2) {
            PG8_LDB(B0, 0, 0); PG8_LDB(B1, 0, 1); PG8_SCHED; PG8_LDA(At, 0, 0); PG8_STAGE(PG8_SA(1, 1), a1 + hstep, voffA);
            PG8_WAIT_V(8); PG8_WAIT_L(0); PG8_BAR;
            PG8_MMA(0, 0, At, B0); PG8_MMA(0, 1, At, B1); PG8_BAR; PG8_SCHED;
            PG8_LDA(At, 0, 1); PG8_STAGE(PG8_SB(0, 0), b2, voffB); PG8_STAGE(PG8_SB(0, 1), b2 + hstep, voffB); PG8_STAGE(PG8_SA(0, 0), a2, voffA);
            PG8_WAIT_V(8); PG8_WAIT_L(0); PG8_BAR; PG8_MMA(1, 0, At, B0); PG8_MMA(1, 1, At, B1); PG8_BAR; PG8_SCHED;
            PG8_LDB(B0, 1, 0); PG8_LDB(B1, 1, 1); PG8_SCHED; PG8_LDA(At, 1, 0); PG8_STAGE(PG8_SA(0, 1), a2 + hstep, voffA);
            PG8_WAIT_V(8); PG8_WAIT_L(0); PG8_BAR; PG8_MMA(0, 0, At, B0); PG8_MMA(0, 1, At, B1); PG8_BAR; PG8_SCHED;
            PG8_LDA(At, 1, 1); PG8_STAGE(PG8_SB(1, 0), b3, voffB); PG8_STAGE(PG8_SB(1, 1), b3 + hstep, voffB); PG8_STAGE(PG8_SA(1, 0), a3, voffA);
            PG8_WAIT_V(8); PG8_WAIT_L(0); PG8_BAR; PG8_MMA(1, 0, At, B0); PG8_MMA(1, 1, At, B1); PG8_BAR; PG8_SCHED;
            } else {
            PG8_LDB(B0, 0, 0); PG8_SCHED; PG8_LDA(At, 0, 0); PG8_STAGE(PG8_SA(1, 1), a1 + hstep, voffA);
            PG8_WAIT_L(8); PG8_BAR; PG8_WAIT_L(0); PG8_MMA(0, 0, At, B0); PG8_BAR; PG8_SCHED;
            PG8_LDB(B1, 0, 1); PG8_STAGE(PG8_SB(0, 0), b2, voffB);
            PG8_BAR; PG8_WAIT_L(0); PG8_MMA(0, 1, At, B1); PG8_BAR;
            PG8_LDA(At, 0, 1); PG8_STAGE(PG8_SA(0, 0), a2, voffA);
            PG8_BAR; PG8_WAIT_L(0); PG8_MMA(1, 0, At, B0); PG8_BAR; PG8_SCHED;
            PG8_STAGE(PG8_SB(0, 1), b2 + hstep, voffB);
            PG8_WAIT_V(6); PG8_BAR; PG8_MMA(1, 1, At, B1); PG8_BAR;
            PG8_LDB(B0, 1, 0); PG8_SCHED; PG8_LDA(At, 1, 0); PG8_STAGE(PG8_SA(0, 1), a2 + hstep, voffA);
            PG8_WAIT_L(8); PG8_BAR; PG8_WAIT_L(0); PG8_MMA(0, 0, At, B0); PG8_BAR; PG8_SCHED;
            PG8_LDB(B1, 1, 1); PG8_STAGE(PG8_SB(1, 0), b3, voffB);
            PG8_BAR; PG8_WAIT_L(0); PG8_MMA(0, 1, At, B1); PG8_BAR;
            PG8_LDA(At, 1, 1); PG8_STAGE(PG8_SA(1, 0), a3, voffA);
            PG8_BAR; PG8_WAIT_L(0); PG8_MMA(1, 0, At, B0); PG8_BAR; PG8_SCHED;
            PG8_STAGE(PG8_SB(1, 1), b3 + hstep, voffB);
            PG8_WAIT_V(6); PG8_BAR; PG8_MMA(1, 1, At, B1); PG8_BAR;
            }
        }
        if constexpr (ALIGN_EPI) { if (wr == 0) PG8_BAR; }
        if constexpr (!Epi::AFTER_DRAIN) { E(acc, cur, wr, wc, fr, fq); S.done(cur); }
        if (!has_next) break;
#pragma unroll
        for (int a = 0; a < 2; ++a)
#pragma unroll
            for (int b = 0; b < 2; ++b)
#pragma unroll
                for (int m = 0; m < 4; ++m)
#pragma unroll
                    for (int n = 0; n < 2; ++n) acc[a][b][m][n] = (f32x4){0.f, 0.f, 0.f, 0.f};
        cur = nxt; cA = nA; cB = nB; ++ui;
        if constexpr (Epi::NEEDS_RSS) { PG8_BAR; PG8_RSS_DMA(cur); }
        if constexpr (ALIGN_EPI) { if (wr == 1) PG8_BAR; }
    }
    PG8_WAIT_V(0);
    if constexpr (!ALIGN_EPI) { if (wr == 0) PG8_BAR; }
    PG8_BAR;
    if constexpr (Epi::AFTER_DRAIN) { E.fused(acc, cur, wr, wc, fr, fq, lds, wid, lane); S.done(cur); }
#undef PG8_RSS_DMA
#undef PG8_SA
#undef PG8_SB
#undef PG8_STAGE
#undef PG8_LDA
#undef PG8_LDB
#undef PG8_MMA
#undef PG8_WAIT_V
#undef PG8_WAIT_L
#undef PG8_BAR
#undef PG8_SCHED
}
}
#define LAS __attribute__((address_space(3)))
typedef unsigned short bf16_t;
typedef unsigned v4u __attribute__((ext_vector_type(4)));
typedef unsigned v2u __attribute__((ext_vector_type(2)));
typedef float f32x4 __attribute__((ext_vector_type(4)));
typedef short bf16x8 __attribute__((ext_vector_type(8)));
#define MFMA16(a, b, c) __builtin_amdgcn_mfma_f32_16x16x32_bf16((a), (b), (c), 0, 0, 0)
#define LDS_WAIT() asm volatile("s_waitcnt lgkmcnt(0)" ::: "memory")

constexpr int M = 10240, DM = 1024, NZ = 2304, FF = 4096, NL = 4, MCTX = 8192;
constexpr int LDS_BYTES = 131072 + 256 + 16384;
constexpr size_t al256(size_t x) { return (x + 255) & ~(size_t)255; }
constexpr size_t WS_BAR = 0;
constexpr size_t WS_MOD = 16384;
constexpr size_t MOD_BYTES = (size_t)4 * 3 * 6144 * 4;
constexpr size_t WS_ROPE = al256(WS_MOD + MOD_BYTES);
constexpr size_t WS_T256 = al256(WS_ROPE + 64 * 16 * 4);
constexpr size_t WS_T1024 = al256(WS_T256 + (size_t)256 * 512 * 2);
constexpr size_t WS_KC = al256(WS_T1024 + (size_t)1024 * 2048 * 2);
constexpr size_t WS_VC = al256(WS_KC + (size_t)2 * 4 * 256 * 256 * 2);
constexpr size_t WS_WSP = al256(WS_VC + (size_t)2 * 4 * 256 * 256 * 2);
constexpr size_t WS_WIN = al256(WS_WSP + (size_t)4 * 4 * 128 * 128 * 2);
constexpr size_t WS_WOUT = al256(WS_WIN + (size_t)4 * 2304 * 1024 * 2);
constexpr size_t WS_W1 = al256(WS_WOUT + (size_t)4 * 1024 * 1024 * 2);
constexpr size_t WS_W2 = al256(WS_W1 + (size_t)4 * 4096 * 1024 * 2);
constexpr size_t WS_XN = al256(WS_W2 + (size_t)4 * 4096 * 1024 * 2);
constexpr size_t WS_Z = al256(WS_XN + (size_t)M * 1024 * 2);
constexpr size_t WS_MIXC = al256(WS_Z + (size_t)M * 2304 * 2);
constexpr size_t WS_X1 = al256(WS_MIXC + (size_t)M * 1024 * 2);
constexpr size_t WS_X = al256(WS_X1 + (size_t)M * 1024 * 4);
constexpr size_t WS_HB = al256(WS_X + (size_t)M * 1024 * 4);
constexpr size_t WS_RSS1 = al256(WS_HB + (size_t)M * 4096 * 2);
constexpr size_t WS_RSS2 = al256(WS_RSS1 + (size_t)M * 16 * 4);
constexpr size_t WS_CV1 = al256(WS_RSS2 + (size_t)M * 16 * 4);
constexpr size_t WS_CV2 = al256(WS_CV1 + (size_t)4 * 3 * 2304 * 4);
constexpr size_t WS_END = al256(WS_CV2 + (size_t)4 * 3 * 4096 * 4);

struct Args { const float* in[29]; float* out; unsigned char* ws; int ph_lo, ph_hi; };
static_assert(sizeof(Args) == 29 * 8 + 8 + 8 + 8, "Args has no padding");

__device__ __forceinline__ unsigned f2bf(float f) { unsigned u = __float_as_uint(f); return (u + 0x7fffu + ((u >> 16) & 1u)) >> 16; }
__device__ __forceinline__ unsigned pk2(float lo, float hi) { return pg8::cvt_pk_bf16(lo, hi); }
__device__ __forceinline__ float bflo(unsigned w) { return __uint_as_float(w << 16); }
__device__ __forceinline__ float bfhi(unsigned w) { return __uint_as_float(w & 0xffff0000u); }
__device__ __forceinline__ float bf2f(bf16_t b) { return __uint_as_float((unsigned)b << 16); }
__device__ __forceinline__ float wave_sum(float v) {
#pragma unroll
    for (int o = 1; o < 64; o <<= 1) v += __shfl_xor(v, o);
    return v;
}
__device__ __forceinline__ float sigmoidf_(float x) { return __builtin_amdgcn_rcpf(1.0f + __expf(-x)); }

#define RLX_AGENT __ATOMIC_RELAXED, __HIP_MEMORY_SCOPE_AGENT
#define XB_TMO      128
#define XB_XCNT(j)  (256  + 64 * (j))
#define XB_XSUB(j)  (1280 + 64 * (j))
#define XB_XGEN(j)  (2304 + 64 * (j))
#define XB_TOP      3328
#define XB_TOPGEN   3392
#define XCD_BAR_WORDS 3456
#define XB_SPIN_CAP (1u << 18)

__device__ __forceinline__ unsigned xb_ld(unsigned* p)              { return __hip_atomic_load(p, __ATOMIC_RELAXED, __HIP_MEMORY_SCOPE_AGENT); }
__device__ __forceinline__ unsigned xb_add(unsigned* p, unsigned v) { return __hip_atomic_fetch_add(p, v, __ATOMIC_RELAXED, __HIP_MEMORY_SCOPE_AGENT); }
__device__ __forceinline__ unsigned xb_xcc_id() { return (unsigned)__builtin_amdgcn_s_getreg((3 << 11) | 20) & 0xFu; }
#define XB_SPIN(cond, bar) do { unsigned _sp = 0; while (cond) { __builtin_amdgcn_s_sleep(1); \
    if ((++_sp & 255u) == 0u) { if (xb_ld(&(bar)[XB_TMO])) break; if (_sp > XB_SPIN_CAP) { atomicAdd(&(bar)[XB_TMO], 1u); break; } } } } while (0)

struct XcdBarrier {
    unsigned* bar; unsigned x;
    volatile LAS unsigned* st;
};

__device__ __forceinline__ XcdBarrier xcd_barrier_post(unsigned* bar, volatile LAS unsigned* st) {
    XcdBarrier b; b.bar = bar; b.x = xb_xcc_id(); b.st = st;
    if (threadIdx.x == 0) (void)xb_add(&bar[XB_XCNT(b.x)], 1u);
    return b;
}
__device__ __forceinline__ void xcd_barrier_complete(unsigned* bar, unsigned x, unsigned& nloc, unsigned& nx) {
    const unsigned G = gridDim.x * gridDim.y * gridDim.z;
    unsigned sum, cnt, mine, sp = 0u;
    for (;;) {
        sum = 0u; cnt = 0u; mine = 0u;
#pragma unroll
        for (unsigned j = 0; j < 16; ++j) { const unsigned c = xb_ld(&bar[XB_XCNT(j)]); sum += c; cnt += (c > 0u) ? 1u : 0u; mine = (j == x) ? c : mine; }
        if (sum == G) break;
        __builtin_amdgcn_s_sleep(1);
        if ((++sp & 255u) == 0u) { if (xb_ld(&bar[XB_TMO])) break; if (sp > XB_SPIN_CAP) { atomicAdd(&bar[XB_TMO], 1u); break; } }
    }
    nloc = mine > 0u ? mine : 1u; nx = cnt > 0u ? cnt : 1u;
}

__device__ __forceinline__ void xcd_barrier(const XcdBarrier& b) {
    asm volatile("s_waitcnt vmcnt(0)" ::: "memory");
    __syncthreads();
    if (threadIdx.x == 0) {
        unsigned* bar = b.bar;
        __builtin_amdgcn_s_waitcnt(0);
        unsigned nloc = b.st[0], nx = b.st[1];
        if (nloc == 0u) { xcd_barrier_complete(bar, b.x, nloc, nx); b.st[0] = nloc; b.st[1] = nx; }
        const unsigned old = xb_add(&bar[XB_XSUB(b.x)], 1u);
        const unsigned gen = old / nloc;
        if (old + 1u == (gen + 1u) * nloc) {
            __builtin_amdgcn_fence(__ATOMIC_RELEASE, "agent");
            asm volatile("s_waitcnt vmcnt(0)" ::: "memory");
            const unsigned og = xb_add(&bar[XB_TOP], 1u);
            const unsigned tg = og / nx;
            if (og + 1u == (tg + 1u) * nx) xb_add(&bar[XB_TOPGEN], 1u);
            else XB_SPIN(xb_ld(&bar[XB_TOPGEN]) == tg, bar);
            __builtin_amdgcn_fence(__ATOMIC_ACQUIRE, "agent");
            xb_add(&bar[XB_XGEN(b.x)], 1u);
            asm volatile("s_waitcnt vmcnt(0)" ::: "memory");
        } else {
            __builtin_amdgcn_fence(__ATOMIC_ACQUIRE, "agent");
            XB_SPIN(xb_ld(&bar[XB_XGEN(b.x)]) == gen, bar);
            asm volatile("s_waitcnt vmcnt(0)" ::: "memory");
        }
    }
    __syncthreads();
}

__device__ __forceinline__ void transpose_item(const float* W, int K, int ldw, int nblk, bf16_t* WT, LAS float* scr, int item, int lane) {
    const int kb = item / nblk, nb = item % nblk, k0 = 64 * kb, n0 = 32 * nb;
    float wv[32];
#pragma unroll
    for (int i = 0; i < 32; ++i) wv[i] = W[(size_t)(k0 + 2 * i + (lane >> 5)) * ldw + n0 + (lane & 31)];
#pragma unroll
    for (int i = 0; i < 32; ++i) scr[(2 * i + (lane >> 5)) * 33 + (lane & 31)] = wv[i];
    LDS_WAIT(); asm volatile("" ::: "memory");
    const int c = lane & 7;
#pragma unroll
    for (int j = 0; j < 4; ++j) { const int n = (lane >> 3) + 8 * j; const LAS float* s = scr + (8 * c) * 33 + n;
        v4u o; o.x = pk2(s[0 * 33], s[1 * 33]); o.y = pk2(s[2 * 33], s[3 * 33]); o.z = pk2(s[4 * 33], s[5 * 33]); o.w = pk2(s[6 * 33], s[7 * 33]);
        *(v4u*)(WT + (size_t)(n0 + n) * K + k0 + 8 * c) = o; }
    LDS_WAIT(); asm volatile("" ::: "memory");
}

__device__ __forceinline__ void weights_layer(const Args& a, LAS unsigned char* lds, int l, int vb, int NB, int tid, int lane, int wave) {
    unsigned char* ws = a.ws;
    const int gw = vb * 8 + wave, NGW = NB * 8;
    LAS float* scr = (LAS float*)(lds + wave * 16384);
    const float* w_in = a.in[10] + (size_t)l * 1024 * 2048; const float* w_out = a.in[26] + (size_t)l * 1024 * 1024; const float* w_ff1 = a.in[27] + (size_t)l * 1024 * 4096; const float* w_ff2 = a.in[28] + (size_t)l * 4096 * 1024;
    bf16_t* WinT = (bf16_t*)(ws + WS_WIN) + (size_t)l * 2304 * 1024; bf16_t* WoutT = (bf16_t*)(ws + WS_WOUT) + (size_t)l * 1024 * 1024; bf16_t* W1T = (bf16_t*)(ws + WS_W1) + (size_t)l * 4096 * 1024; bf16_t* W2T = (bf16_t*)(ws + WS_W2) + (size_t)l * 1024 * 4096;
    constexpr int I_IN = 16 * 56, I_OUT = 16 * 32, I_F1 = 16 * 128, I_F2 = 64 * 32, I_L = I_IN + I_OUT + I_F1 + I_F2;
    for (int it = gw; it < I_L; it += NGW) {
        int r = it;
        if (r < I_IN) { transpose_item(w_in, 1024, 2048, 56, WinT, scr, r, lane); continue; } r -= I_IN;
        if (r < I_OUT) { transpose_item(w_out, 1024, 1024, 32, WoutT, scr, r, lane); continue; } r -= I_OUT;
        if (r < I_F1) { transpose_item(w_ff1, 1024, 4096, 128, W1T, scr, r, lane); continue; } r -= I_F1;
        transpose_item(w_ff2, 4096, 1024, 32, W2T, scr, r, lane);
    }
    __syncthreads();
    for (int it = vb; it < 128; it += NB) {
        const int g = (it >> 5) & 3, kb = it & 31, k0 = kb * 32;
        LAS float* wt = (LAS float*)lds; LAS float* tw = wt + 2048;
        *(LAS f32x4*)(wt + tid * 4) = *(const f32x4*)(w_in + ((size_t)k0 + (tid >> 4)) * 2048 + 1792 + g * 64 + (tid & 15) * 4);
        if (tid < 64) { tw[tid] = __builtin_amdgcn_cosf((float)tid * (1.0f / 64.0f)); tw[64 + tid] = __builtin_amdgcn_sinf((float)tid * (1.0f / 64.0f)); }
        __syncthreads();
        const int m = tid & 63, cs = (tid >> 6) & 1, kq = tid >> 7;
        float o[8];
#pragma unroll
        for (int kk = 0; kk < 8; ++kk) o[kk] = 0.f;
        for (int c = 0; c < 64; ++c) { const float t = tw[cs * 64 + ((m * c) & 63)];
#pragma unroll
            for (int kk = 0; kk < 8; ++kk) o[kk] += wt[(kq * 8 + kk) * 64 + c] * t; }
        v4u pk; pk.x = pk2(o[0], o[1]); pk.y = pk2(o[2], o[3]); pk.z = pk2(o[4], o[5]); pk.w = pk2(o[6], o[7]);
        *(v4u*)(WinT + ((size_t)1792 + cs * 256 + g * 64 + m) * 1024 + k0 + kq * 8) = pk;
        __syncthreads();
    }
}

__device__ __forceinline__ void mod_items(const Args& a, int l_lo, int l_hi, int vw, int NW, int lane) {
    float* mod = (float*)(a.ws + WS_MOD);
    for (int it = l_lo * 384 + vw; it < l_hi * 384; it += NW) {
        const int l = it / 384, cb = it % 384;
        const int ks = lane >> 2, col = cb * 16 + (lane & 3) * 4;
        f32x4 a0 = {0.f, 0.f, 0.f, 0.f}, a1 = a0, a2 = a0;
        const float* wp = a.in[6] + ((size_t)l * 1024 + ks) * 6144 + col;
#pragma unroll 16
        for (int kk = 0; kk < 64; ++kk) { const int k = kk * 16 + ks; const f32x4 w = *(const f32x4*)(wp + (size_t)kk * 16 * 6144);
            const float x0 = a.in[5][k], x1 = a.in[2][k], x2 = a.in[2][1024 + k];
            a0 += w * (x0 * sigmoidf_(x0)); a1 += w * (x1 * sigmoidf_(x1)); a2 += w * (x2 * sigmoidf_(x2)); }
#pragma unroll
        for (int o = 4; o < 64; o <<= 1)
#pragma unroll
            for (int j = 0; j < 4; ++j) { a0[j] += __shfl_xor(a0[j], o); a1[j] += __shfl_xor(a1[j], o); a2[j] += __shfl_xor(a2[j], o); }
        if (ks == 0) { const f32x4 bb = *(const f32x4*)(a.in[7] + (size_t)l * 6144 + col); float* mp = mod + (size_t)(l * 3) * 6144 + col;
            *(f32x4*)mp = a0 + bb; *(f32x4*)(mp + 6144) = a1 + bb; *(f32x4*)(mp + 2 * 6144) = a2 + bb; }
    }
}

__device__ __forceinline__ void p0_prologue(const Args& a, LAS unsigned char* lds, int tid, int lane, int wave) {
    unsigned char* ws = a.ws;
    const int gw = blockIdx.x * 8 + wave, NGW = gridDim.x * 8;
    float* mod = (float*)(ws + WS_MOD);
    mod_items(a, 0, NL, gw, NGW, lane);
    { const int nlw = (int)gridDim.x > 160 ? 1 : NL;
      for (int lw = 0; lw < nlw; ++lw) { weights_layer(a, lds, lw, blockIdx.x, gridDim.x, tid, lane, wave); __syncthreads(); } }
    const int gt = blockIdx.x * 512 + tid, GT = gridDim.x * 512;
    { const f32x4* ck = (const f32x4*)a.in[3]; const f32x4* cv = (const f32x4*)a.in[4]; v2u* KC = (v2u*)(ws + WS_KC); v2u* VC = (v2u*)(ws + WS_VC);
      for (int i = gt; i < 524288 / 4; i += GT) { const f32x4 k = ck[i], v = cv[i]; KC[i] = (v2u){pk2(k[0], k[1]), pk2(k[2], k[3])}; VC[i] = (v2u){pk2(v[0], v[1]), pk2(v[2], v[3])}; }
      const f32x4* wsp = (const f32x4*)a.in[20]; v2u* WSP = (v2u*)(ws + WS_WSP);
      for (int i = gt; i < 262144 / 4; i += GT) { const f32x4 k = wsp[i]; WSP[i] = (v2u){pk2(k[0], k[1]), pk2(k[2], k[3])}; } }
    { bf16_t* T256 = (bf16_t*)(ws + WS_T256);
      for (int i = gt; i < 256 * 512; i += GT) { const int k = i >> 9, j = i & 511, n = j & 255, r = (k * n) & 255; const float fr = (float)r * (1.0f / 256.0f);
          const float v = (j >= 256) ? -__builtin_amdgcn_sinf(fr) : __builtin_amdgcn_cosf(fr); T256[i] = (bf16_t)f2bf(v * (1.0f / 128.0f)); }
      bf16_t* T1024 = (bf16_t*)(ws + WS_T1024);
      for (int i = gt; i < 1024 * 2048; i += GT) { const int k = i >> 11, j = i & 2047, n = j & 1023, r = (k * n) & 1023; const float fr = (float)r * (1.0f / 1024.0f);
          const float v = (j >= 1024) ? -__builtin_amdgcn_sinf(fr) : __builtin_amdgcn_cosf(fr); T1024[i] = (bf16_t)f2bf(v * (1.0f / 256.0f)); }
      float* rope = (float*)(ws + WS_ROPE);
      if (gt < 512) { const int pos = gt >> 3, f = gt & 7; const float inv = __builtin_amdgcn_exp2f(-(float)f * 1.6609640474436813f); float rev = (float)pos * inv * 0.15915494309189535f; rev -= floorf(rev);
          rope[pos * 16 + f] = __builtin_amdgcn_cosf(rev); rope[pos * 16 + 8 + f] = __builtin_amdgcn_sinf(rev); } }
}

__device__ __forceinline__ void norm_phase(const float* src0, const float* src1, const float* gnorm, const float* modl, int shi, int sci, bf16_t* XN, int lane, int wave) {
    const int gw = blockIdx.x * 8 + wave, NGW = gridDim.x * 8;
    for (int row = gw; row < M; row += NGW) {
        const float* xr = row < MCTX ? src0 + (size_t)row * 1024 : src1 + (size_t)(row - MCTX) * 1024;
        const int cond = row < MCTX ? 0 : 1 + ((row - MCTX) >> 10);
        const float* mp = modl + cond * 6144;
        f32x4 v[4]; float s = 0.f;
#pragma unroll
        for (int j = 0; j < 4; ++j) { v[j] = ((const f32x4*)xr)[lane + 64 * j]; s += (v[j][0] * v[j][0] + v[j][1] * v[j][1]) + (v[j][2] * v[j][2] + v[j][3] * v[j][3]); }
        const float rinv = rsqrtf(wave_sum(s) * (1.0f / 1024.0f) + 1e-6f);
#pragma unroll
        for (int j = 0; j < 4; ++j) { const int col = 4 * (lane + 64 * j);
            const f32x4 g = *(const f32x4*)(gnorm + col), sc = *(const f32x4*)(mp + sci * 1024 + col), sh = *(const f32x4*)(mp + shi * 1024 + col);
            const f32x4 h = v[j] * rinv * g * (sc + 1.0f) + sh;
            *(v2u*)(XN + (size_t)row * 1024 + col) = (v2u){pk2(h[0], h[1]), pk2(h[2], h[3])}; }
    }
}

__device__ __forceinline__ void cvec_layer(const Args& a, int l, int vw, int NW, int lane) {
    unsigned char* ws = a.ws; const float* modl = (const float*)(ws + WS_MOD) + (size_t)l * 3 * 6144;
    const bf16_t* WinT = (const bf16_t*)(ws + WS_WIN) + (size_t)l * 2304 * 1024; const bf16_t* W1T = (const bf16_t*)(ws + WS_W1) + (size_t)l * 4096 * 1024;
    float* cv1 = (float*)(ws + WS_CV1) + (size_t)l * 3 * 2304; float* cv2 = (float*)(ws + WS_CV2) + (size_t)l * 3 * 4096;
    for (int it = vw; it < 2304 + 4096; it += NW) {
        const bool first = it < 2304; const int n = first ? it : it - 2304; const int N = first ? 2304 : 4096;
        const bf16_t* wrow = (first ? WinT : W1T) + (size_t)n * 1024 + lane * 16; const float* sh = modl + (first ? 0 : 3 * 1024) + lane * 16; float* dst = first ? cv1 : cv2;
        const v4u w0 = *(const v4u*)wrow, w1 = *(const v4u*)(wrow + 8);
        float d[3];
#pragma unroll
        for (int c = 0; c < 3; ++c) { const f32x4 s0 = *(const f32x4*)(sh + c * 6144), s1 = *(const f32x4*)(sh + c * 6144 + 4), s2 = *(const f32x4*)(sh + c * 6144 + 8), s3 = *(const f32x4*)(sh + c * 6144 + 12);
            float t = bflo(w0[0]) * s0[0] + bfhi(w0[0]) * s0[1] + bflo(w0[1]) * s0[2] + bfhi(w0[1]) * s0[3];
            t += bflo(w0[2]) * s1[0] + bfhi(w0[2]) * s1[1] + bflo(w0[3]) * s1[2] + bfhi(w0[3]) * s1[3];
            t += bflo(w1[0]) * s2[0] + bfhi(w1[0]) * s2[1] + bflo(w1[1]) * s2[2] + bfhi(w1[1]) * s2[3];
            t += bflo(w1[2]) * s3[0] + bfhi(w1[2]) * s3[1] + bflo(w1[3]) * s3[2] + bfhi(w1[3]) * s3[3];
            d[c] = wave_sum(t); }
        if (lane == 0) { dst[n] = d[0]; dst[N + n] = d[1]; dst[2 * N + n] = d[2]; }
    }
}
__device__ __forceinline__ void prep_phase(const Args& a, int lane, int wave) {
    unsigned char* ws = a.ws; const float* modl = (const float*)(ws + WS_MOD);
    bf16_t* XN = (bf16_t*)(ws + WS_XN); float* rss = (float*)(ws + WS_RSS1);
    const int gw = blockIdx.x * 8 + wave, NGW = gridDim.x * 8;
    for (int row = gw; row < M; row += NGW) {
        const float* xr = row < MCTX ? a.in[0] + (size_t)row * 1024 : a.in[1] + (size_t)(row - MCTX) * 1024;
        const int cond = row < MCTX ? 0 : 1 + ((row - MCTX) >> 10);
        const float* mp = modl + cond * 6144;
        float s = 0.f;
#pragma unroll
        for (int j = 0; j < 4; ++j) { const int col = 4 * (lane + 64 * j); const f32x4 v = ((const f32x4*)xr)[lane + 64 * j]; s += (v[0] * v[0] + v[1] * v[1]) + (v[2] * v[2] + v[3] * v[3]);
            const f32x4 h = v * (*(const f32x4*)(a.in[8] + col)) * (*(const f32x4*)(mp + 1024 + col) + 1.0f);
            *(v2u*)(XN + (size_t)row * 1024 + col) = (v2u){pk2(h[0], h[1]), pk2(h[2], h[3])}; }
        s = wave_sum(s);
        if (lane < 16) rss[(size_t)row * 16 + lane] = lane == 0 ? s : 0.f;
    }
    cvec_layer(a, 0, gw, NGW, lane);
}

__device__ __forceinline__ void attn_item(LAS unsigned char* lds, const bf16_t* Z, const bf16_t* KC, const bf16_t* VC, bf16_t* MIXC, const float* ghead,
                                          int l, float lam, float lam_init, bool is_lat, int b, int h, int qb, int tid, int lane, int wave) {
    LAS bf16_t* Ks = (LAS bf16_t*)lds;
    LAS bf16_t* Vt = (LAS bf16_t*)(lds + 256 * 72 * 2);
    const int g = lane >> 4, li = lane & 15;
    const int seq0 = is_lat ? MCTX + b * 1024 : b * 256;
    const int qrow = seq0 + qb * 128 + wave * 16 + li;
    bf16x8 qf[2];
    qf[0] = *(const bf16x8*)(Z + (size_t)qrow * NZ + h * 64 + 8 * g);
    qf[1] = *(const bf16x8*)(Z + (size_t)qrow * NZ + h * 64 + 32 + 8 * g);
    f32x4 O[2][4];
#pragma unroll
    for (int c = 0; c < 2; ++c)
#pragma unroll
        for (int d = 0; d < 4; ++d) O[c][d] = (f32x4){0.f, 0.f, 0.f, 0.f};
    float lsum0 = 0.f, lsum1 = 0.f;
    const int ns = is_lat ? 5 : 1;
    v4u kreg[4], vreg[4];
#define ATT_LOAD(stg) do { const bf16_t* kb_; const bf16_t* vb_; int st_; \
        if (is_lat && (stg) == 0) { const size_t o_ = ((size_t)(b * 4 + l) * 256) * 256 + h * 64; kb_ = KC + o_; vb_ = VC + o_; st_ = 256; } \
        else { const int row_ = is_lat ? seq0 + ((stg) - 1) * 256 : seq0; kb_ = Z + (size_t)row_ * NZ + 256 + h * 64; vb_ = Z + (size_t)row_ * NZ + 512 + h * 64; st_ = NZ; } \
        _Pragma("unroll") for (int i_ = 0; i_ < 4; ++i_) { const int idx_ = tid + 512 * i_; kreg[i_] = *(const v4u*)(kb_ + (size_t)(idx_ >> 3) * st_ + (idx_ & 7) * 8); } \
        _Pragma("unroll") for (int i_ = 0; i_ < 2; ++i_) { const int idx_ = tid + 512 * i_, kp_ = idx_ >> 3, ch_ = idx_ & 7; vreg[2 * i_] = *(const v4u*)(vb_ + (size_t)(2 * kp_) * st_ + ch_ * 8); vreg[2 * i_ + 1] = *(const v4u*)(vb_ + (size_t)(2 * kp_ + 1) * st_ + ch_ * 8); } } while (0)
    ATT_LOAD(0);
#pragma unroll 1
    for (int s = 0; s < ns; ++s) {
#pragma unroll
        for (int i = 0; i < 4; ++i) { const int idx = tid + 512 * i; *(LAS v4u*)(Ks + (idx >> 3) * 72 + (idx & 7) * 8) = kreg[i]; }
#pragma unroll
        for (int i = 0; i < 2; ++i) { const int idx = tid + 512 * i, kp = idx >> 3, ch = idx & 7; const v4u v0 = vreg[2 * i], v1 = vreg[2 * i + 1];
#pragma unroll
            for (int e = 0; e < 4; ++e) { *(LAS unsigned*)(Vt + (ch * 8 + 2 * e) * 264 + 2 * kp) = (v0[e] & 0xffffu) | (v1[e] << 16); *(LAS unsigned*)(Vt + (ch * 8 + 2 * e + 1) * 264 + 2 * kp) = (v0[e] >> 16) | (v1[e] & 0xffff0000u); } }
        __syncthreads();
        if (s + 1 < ns) ATT_LOAD(s + 1);
#pragma unroll 1
        for (int kq = 0; kq < 4; ++kq) {
            const LAS bf16_t* Kq = Ks + kq * 64 * 72; const LAS bf16_t* Vq = Vt + kq * 64;
            f32x4 st[2][4];
#pragma unroll
            for (int kt = 0; kt < 4; ++kt)
#pragma unroll
                for (int c = 0; c < 2; ++c) { const bf16x8 af = *(const LAS bf16x8*)(Kq + (kt * 16 + li) * 72 + c * 32 + 8 * g); st[c][kt] = MFMA16(af, qf[c], ((f32x4){0.f, 0.f, 0.f, 0.f})); }
#pragma unroll
            for (int kt = 0; kt < 4; ++kt)
#pragma unroll
                for (int j = 0; j < 4; ++j) { const float p0 = __builtin_amdgcn_exp2f(st[0][kt][j]), p1 = __builtin_amdgcn_exp2f(st[1][kt][j]); lsum0 += p0; lsum1 += p1; st[0][kt][j] = p0; st[1][kt][j] = p1; }
#pragma unroll
            for (int ks = 0; ks < 2; ++ks) {
                bf16x8 pb[2];
#pragma unroll
                for (int c = 0; c < 2; ++c) { v4u w; w.x = pk2(st[c][2 * ks][0], st[c][2 * ks][1]); w.y = pk2(st[c][2 * ks][2], st[c][2 * ks][3]); w.z = pk2(st[c][2 * ks + 1][0], st[c][2 * ks + 1][1]); w.w = pk2(st[c][2 * ks + 1][2], st[c][2 * ks + 1][3]); pb[c] = __builtin_bit_cast(bf16x8, w); }
#pragma unroll
                for (int dt = 0; dt < 4; ++dt) { const LAS bf16_t* vp = Vq + (dt * 16 + li) * 264 + 32 * ks + 4 * g;
                    const v2u lo = *(const LAS v2u*)vp, hi = *(const LAS v2u*)(vp + 16);
                    const bf16x8 af = __builtin_bit_cast(bf16x8, ((v4u){lo.x, lo.y, hi.x, hi.y}));
                    O[0][dt] = MFMA16(af, pb[0], O[0][dt]); O[1][dt] = MFMA16(af, pb[1], O[1][dt]); }
            }
        }
        __syncthreads();
    }
#undef ATT_LOAD
    lsum0 += __shfl_xor(lsum0, 16); lsum0 += __shfl_xor(lsum0, 32); lsum1 += __shfl_xor(lsum1, 16); lsum1 += __shfl_xor(lsum1, 32);
    const float i0 = __builtin_amdgcn_rcpf(lsum0), i1 = lam * __builtin_amdgcn_rcpf(lsum1);
    float ssq = 0.f;
#pragma unroll
    for (int dt = 0; dt < 4; ++dt) { O[0][dt] = O[0][dt] * i0 - O[1][dt] * i1; ssq += (O[0][dt][0] * O[0][dt][0] + O[0][dt][1] * O[0][dt][1]) + (O[0][dt][2] * O[0][dt][2] + O[0][dt][3] * O[0][dt][3]); }
    ssq += __shfl_xor(ssq, 16); ssq += __shfl_xor(ssq, 32);
    const float rs = rsqrtf(ssq * (1.0f / 64.0f) + 1e-6f) * (1.0f - lam_init);
#pragma unroll
    for (int dt = 0; dt < 4; ++dt) { const f32x4 gh = *(const f32x4*)(ghead + dt * 16 + 4 * g); const f32x4 o = O[0][dt] * rs * gh;
        *(v2u*)(MIXC + (size_t)qrow * 1024 + h * 64 + dt * 16 + 4 * g) = (v2u){pk2(o[0], o[1]), pk2(o[2], o[3])}; }
}

__device__ __forceinline__ void gating_item(LAS unsigned char* lds, const bf16_t* Z, const bf16_t* WSP, bf16_t* MIXC, const float* g_sg, const float* b_sg, const float* b_sp,
                                            int l, int chunk, int tid, int lane, int wave) {
    LAS bf16_t* vnT = (LAS bf16_t*)lds;
    const int r0 = chunk * 128;
    bf16x8 afr[4][4];
    { const int gq_ = lane >> 4, li_ = lane & 15;
#pragma unroll
      for (int g = 0; g < 4; ++g)
#pragma unroll
          for (int ks = 0; ks < 4; ++ks) afr[g][ks] = *(const bf16x8*)(WSP + ((size_t)(l * 4 + g) * 128 + wave * 16 + li_) * 128 + ks * 32 + 8 * gq_); }
    { const int tp = tid >> 3, part = tid & 7;
      const v4u* src0 = (const v4u*)(Z + (size_t)(r0 + 2 * tp) * NZ + 1024 + part * 32); const v4u* src1 = (const v4u*)(Z + (size_t)(r0 + 2 * tp + 1) * NZ + 1024 + part * 32);
      v4u ra[4], rb[4]; float sa = 0.f, sb = 0.f;
#pragma unroll
      for (int i = 0; i < 4; ++i) { ra[i] = src0[i]; rb[i] = src1[i];
#pragma unroll
          for (int e = 0; e < 4; ++e) { sa += bflo(ra[i][e]) + bfhi(ra[i][e]); sb += bflo(rb[i][e]) + bfhi(rb[i][e]); } }
      sa += __shfl_xor(sa, 1); sa += __shfl_xor(sa, 2); sa += __shfl_xor(sa, 4); sb += __shfl_xor(sb, 1); sb += __shfl_xor(sb, 2); sb += __shfl_xor(sb, 4);
      const float ma = sa * (1.0f / 256.0f), mb = sb * (1.0f / 256.0f); float qa = 0.f, qb = 0.f;
#pragma unroll
      for (int i = 0; i < 4; ++i)
#pragma unroll
          for (int e = 0; e < 4; ++e) { const float d0 = bflo(ra[i][e]) - ma, d1 = bfhi(ra[i][e]) - ma, e0 = bflo(rb[i][e]) - mb, e1 = bfhi(rb[i][e]) - mb; qa += d0 * d0 + d1 * d1; qb += e0 * e0 + e1 * e1; }
      qa += __shfl_xor(qa, 1); qa += __shfl_xor(qa, 2); qa += __shfl_xor(qa, 4); qb += __shfl_xor(qb, 1); qb += __shfl_xor(qb, 2); qb += __shfl_xor(qb, 4);
      const float rsa = rsqrtf(qa * (1.0f / 256.0f) + 1e-6f), rsb = rsqrtf(qb * (1.0f / 256.0f) + 1e-6f);
#pragma unroll
      for (int i = 0; i < 4; ++i)
#pragma unroll
          for (int e = 0; e < 4; ++e) { const int ch = part * 32 + i * 8 + 2 * e;
              const float g0 = g_sg[l * 256 + ch], g1 = g_sg[l * 256 + ch + 1], b0 = b_sg[l * 256 + ch], b1 = b_sg[l * 256 + ch + 1];
              *(LAS unsigned*)(vnT + ch * 136 + 2 * tp) = pk2((bflo(ra[i][e]) - ma) * rsa * g0 + b0, (bflo(rb[i][e]) - mb) * rsb * g0 + b0);
              *(LAS unsigned*)(vnT + (ch + 1) * 136 + 2 * tp) = pk2((bfhi(ra[i][e]) - ma) * rsa * g1 + b1, (bfhi(rb[i][e]) - mb) * rsb * g1 + b1); } }
    __syncthreads();
    const int gq = lane >> 4, li = lane & 15, p0 = wave * 16;
#pragma unroll
    for (int g = 0; g < 4; ++g) {
        f32x4 acc[4];
#pragma unroll
        for (int nt = 0; nt < 4; ++nt) acc[nt] = (f32x4){0.f, 0.f, 0.f, 0.f};
#pragma unroll
        for (int ks = 0; ks < 4; ++ks) { const bf16x8 af = afr[g][ks];
#pragma unroll
            for (int nt = 0; nt < 4; ++nt) { const bf16x8 bfr = *(const LAS bf16x8*)(vnT + (g * 64 + nt * 16 + li) * 136 + ks * 32 + 8 * gq); acc[nt] = MFMA16(af, bfr, acc[nt]); } }
#pragma unroll
        for (int nt = 0; nt < 4; ++nt)
#pragma unroll
            for (int j = 0; j < 4; ++j) { const int p = p0 + 4 * gq + j, ch = g * 64 + nt * 16 + li; const float bs = b_sp[(l * 4 + g) * 128 + p];
                const float uu = bf2f(Z[(size_t)(r0 + p) * NZ + 768 + ch]);
                MIXC[(size_t)(r0 + p) * 1024 + 256 + ch] = (bf16_t)f2bf(uu * (acc[nt][j] + bs)); }
    }
    __syncthreads();
}

__device__ __forceinline__ void conv_item(LAS unsigned char* lds, const bf16_t* Z, bf16_t* MIXC, const float* w_dw, const float* b_dw, const float* g_cv, const float* b_cv,
                                          int l, int ci, int tid) {
    LAS bf16_t* hs = (LAS bf16_t*)lds;
    LAS float* ys = (LAS float*)(lds + 49152);
    const int r0 = ci * 64;
    int s0, L; if (r0 < MCTX) { s0 = r0 & ~255; L = 256; } else { s0 = MCTX + ((r0 - MCTX) & ~1023); L = 1024; }
    const int t0 = r0 - s0;
    { v4u av[6], gv[6];
#pragma unroll
      for (int i = 0; i < 6; ++i) { const int idx = tid + 512 * i, rr = idx >> 5, c8 = idx & 31, tt = t0 + rr - 15; av[i] = (v4u){0u, 0u, 0u, 0u}; gv[i] = av[i];
          if (idx < 94 * 32 && tt >= 0 && tt < L) { const bf16_t* p = Z + (size_t)(s0 + tt) * NZ + 1280 + c8 * 8; av[i] = *(const v4u*)p; gv[i] = *(const v4u*)(p + 256); } }
#pragma unroll
      for (int i = 0; i < 6; ++i) { const int idx = tid + 512 * i, rr = idx >> 5, c8 = idx & 31; v4u o;
#pragma unroll
          for (int e = 0; e < 4; ++e) o[e] = pk2(bflo(av[i][e]) * sigmoidf_(bflo(gv[i][e])), bfhi(av[i][e]) * sigmoidf_(bfhi(gv[i][e])));
          if (idx < 94 * 32) *(LAS v4u*)(hs + rr * 256 + c8 * 8) = o; } }
    __syncthreads();
    { const int ch = tid & 255, th = tid >> 8;
      float w[31];
#pragma unroll
      for (int j = 0; j < 31; ++j) w[j] = w_dw[(l * 31 + j) * 256 + ch];
      const float bias = b_dw[l * 256 + ch];
#pragma unroll 1
      for (int blk = 0; blk < 4; ++blk) { const int tb = th * 32 + blk * 8; float acc[8];
#pragma unroll
          for (int o = 0; o < 8; ++o) acc[o] = bias;
#pragma unroll
          for (int i = 0; i < 38; ++i) { const float hv = bf2f(hs[(tb + i) * 256 + ch]);
#pragma unroll
              for (int o = 0; o < 8; ++o) { const int j = i - o; if (j >= 0 && j < 31) acc[o] += hv * w[j]; } }
#pragma unroll
          for (int o = 0; o < 8; ++o) ys[(tb + o) * 256 + ch] = acc[o]; } }
    __syncthreads();
    { const int token = tid >> 3, part = tid & 7; const LAS f32x4* yp = (const LAS f32x4*)(ys + token * 256 + part * 32);
      f32x4 v[8]; float s = 0.f;
#pragma unroll
      for (int i = 0; i < 8; ++i) { v[i] = yp[i]; s += (v[i][0] + v[i][1]) + (v[i][2] + v[i][3]); }
      s += __shfl_xor(s, 1); s += __shfl_xor(s, 2); s += __shfl_xor(s, 4); const float mean = s * (1.0f / 256.0f); float q = 0.f;
#pragma unroll
      for (int i = 0; i < 8; ++i) { v[i] = v[i] - mean; q += (v[i][0] * v[i][0] + v[i][1] * v[i][1]) + (v[i][2] * v[i][2] + v[i][3] * v[i][3]); }
      q += __shfl_xor(q, 1); q += __shfl_xor(q, 2); q += __shfl_xor(q, 4); const float rstd = rsqrtf(q * (1.0f / 256.0f) + 1e-6f);
      bf16_t* op = MIXC + (size_t)(r0 + token) * 1024 + 512 + part * 32;
#pragma unroll
      for (int i = 0; i < 4; ++i) { const int ch = part * 32 + i * 8;
          const f32x4 g0 = *(const f32x4*)(g_cv + l * 256 + ch), g1 = *(const f32x4*)(g_cv + l * 256 + ch + 4), b0 = *(const f32x4*)(b_cv + l * 256 + ch), b1 = *(const f32x4*)(b_cv + l * 256 + ch + 4);
          f32x4 y0 = v[2 * i] * rstd * g0 + b0, y1 = v[2 * i + 1] * rstd * g1 + b1;
#pragma unroll
          for (int e = 0; e < 4; ++e) { y0[e] = y0[e] * sigmoidf_(y0[e]); y1[e] = y1[e] * sigmoidf_(y1[e]); }
          *(v4u*)(op + i * 8) = (v4u){pk2(y0[0], y0[1]), pk2(y0[2], y0[3]), pk2(y1[0], y1[1]), pk2(y1[2], y1[3])}; } }
    __syncthreads();
}

__device__ __forceinline__ void fourier_item(LAS unsigned char* lds, const bf16_t* Z, const bf16_t* T, bf16_t* MIXC, int L, int s0, int g, int rb, int tid, int lane, int wave) {
    LAS bf16_t* yt = (LAS bf16_t*)lds;
    const int gq = lane >> 4, li = lane & 15;
    const int krow = rb * 128 + wave * 16 + li; const int ldt = 2 * L;
    f32x4 acc[4];
#pragma unroll
    for (int nt = 0; nt < 4; ++nt) acc[nt] = (f32x4){0.f, 0.f, 0.f, 0.f};
    const int ns = L >> 8;
    v4u zr[8];
#define FOU_LOAD(stg) do { _Pragma("unroll") for (int i_ = 0; i_ < 2; ++i_) { const int idx_ = tid + 512 * i_, tp_ = idx_ >> 3, part_ = idx_ & 7; \
        const v4u* s0_ = (const v4u*)(Z + (size_t)(s0 + (stg) * 256 + 2 * tp_) * NZ + 1792 + (part_ >> 2) * 256 + g * 64 + (part_ & 3) * 16); const v4u* s1_ = (const v4u*)((const bf16_t*)s0_ + NZ); \
        zr[4 * i_] = s0_[0]; zr[4 * i_ + 1] = s0_[1]; zr[4 * i_ + 2] = s1_[0]; zr[4 * i_ + 3] = s1_[1]; } } while (0)
    FOU_LOAD(0);
#pragma unroll 1
    for (int s = 0; s < ns; ++s) {
#pragma unroll
        for (int i = 0; i < 2; ++i) { const int idx = tid + 512 * i, tp = idx >> 3, part = idx & 7; const v4u a0 = zr[4 * i], a1 = zr[4 * i + 1], b0 = zr[4 * i + 2], b1 = zr[4 * i + 3];
            LAS bf16_t* d = yt + (part * 16) * 264 + 2 * tp;
#pragma unroll
            for (int e = 0; e < 4; ++e) {
                *(LAS unsigned*)(d + (2 * e) * 264) = (a0[e] & 0xffffu) | (b0[e] << 16); *(LAS unsigned*)(d + (2 * e + 1) * 264) = (a0[e] >> 16) | (b0[e] & 0xffff0000u);
                *(LAS unsigned*)(d + (8 + 2 * e) * 264) = (a1[e] & 0xffffu) | (b1[e] << 16); *(LAS unsigned*)(d + (9 + 2 * e) * 264) = (a1[e] >> 16) | (b1[e] & 0xffff0000u); } }
        __syncthreads();
        if (s + 1 < ns) FOU_LOAD(s + 1);
#pragma unroll
        for (int cs = 0; cs < 2; ++cs) {
            bf16x8 af[8];
#pragma unroll
            for (int ks = 0; ks < 8; ++ks) af[ks] = *(const bf16x8*)(T + (size_t)krow * ldt + cs * L + s * 256 + ks * 32 + 8 * gq);
#pragma unroll
            for (int ks = 0; ks < 8; ++ks)
#pragma unroll
                for (int nt = 0; nt < 4; ++nt) { const bf16x8 bfr = *(const LAS bf16x8*)(yt + (cs * 64 + nt * 16 + li) * 264 + ks * 32 + 8 * gq); acc[nt] = MFMA16(af[ks], bfr, acc[nt]); }
        }
        __syncthreads();
    }
#undef FOU_LOAD
#pragma unroll
    for (int nt = 0; nt < 4; ++nt)
#pragma unroll
        for (int j = 0; j < 4; ++j) MIXC[(size_t)(s0 + rb * 128 + wave * 16 + 4 * gq + j) * 1024 + 768 + g * 64 + nt * 16 + li] = (bf16_t)f2bf(acc[nt][j]);
}

#ifndef MIXMASK
#define MIXMASK 15
#endif
__device__ __forceinline__ void mix_phase(const Args& a, LAS unsigned char* lds, const int l, const int tid_outer, int, int) {
    unsigned char* ws = a.ws;
    const bf16_t* Z = (const bf16_t*)(ws + WS_Z); bf16_t* MIXC = (bf16_t*)(ws + WS_MIXC);
    float d1 = 0.f, d2 = 0.f;
    for (int i = 0; i < 32; ++i) { d1 += a.in[13][l * 32 + i] * a.in[14][l * 32 + i]; d2 += a.in[15][l * 32 + i] * a.in[16][l * 32 + i]; }
    const float lam_init = 0.8f - 0.6f * __expf(-0.3f * (float)l);
    const float lam = __expf(d1) - __expf(d2) + lam_init;
    const int l_outer = l;
    unsigned* qctr = (unsigned*)(ws + WS_BAR) + 3584 + 64 * l;
    LAS int* qslot = (LAS int*)(lds + 131072 + 64);
    const int nstat = 2 * (int)gridDim.x <= 880 ? 2 : 0;
    for (int kq_ = 0;; ++kq_) {
        int it;
        if (kq_ < nstat) it = (int)blockIdx.x + kq_ * (int)gridDim.x;
        else {
            if (tid_outer == 0) *qslot = nstat * (int)gridDim.x + (int)__hip_atomic_fetch_add(qctr, 1u, __ATOMIC_RELAXED, __HIP_MEMORY_SCOPE_AGENT);
            __syncthreads();
            it = *qslot;
            __syncthreads();
        }
        if (it >= 880) break;
        int tid = tid_outer; asm volatile("" : "+v"(tid));
        const int lane = tid & 63, wave = __builtin_amdgcn_readfirstlane(tid >> 6);
        int l = l_outer; asm volatile("" : "+s"(l));
        if (it < 64) { if ((MIXMASK & 1) && !(MIXMASK & 16)) attn_item(lds, Z, (const bf16_t*)(ws + WS_KC), (const bf16_t*)(ws + WS_VC), MIXC, a.in[17] + l * 64, l, lam, lam_init, true, it >> 5, (it >> 3) & 3, it & 7, tid, lane, wave); }
        else if (it < 128) { const int r = it - 64; if (MIXMASK & 2) fourier_item(lds, Z, (const bf16_t*)(ws + WS_T1024), MIXC, 1024, MCTX + (r >> 5) * 1024, (r >> 3) & 3, r & 7, tid, lane, wave); }
        else if (it < 208) { if (MIXMASK & 4) gating_item(lds, Z, (const bf16_t*)(ws + WS_WSP), MIXC, a.in[18], a.in[19], a.in[21], l, it - 128, tid, lane, wave); }
        else if (it < 368) { if (MIXMASK & 8) conv_item(lds, Z, MIXC, a.in[22], a.in[23], a.in[24], a.in[25], l, it - 208, tid); }
        else if (it < 624) { const int r = it - 368; if ((MIXMASK & 1) && !(MIXMASK & 32)) attn_item(lds, Z, (const bf16_t*)(ws + WS_KC), (const bf16_t*)(ws + WS_VC), MIXC, a.in[17] + l * 64, l, lam, lam_init, false, r >> 3, (r >> 1) & 3, r & 1, tid, lane, wave); }
        else { const int r = it - 624; if (MIXMASK & 2) fourier_item(lds, Z, (const bf16_t*)(ws + WS_T256), MIXC, 256, (r >> 3) * 256, (r >> 1) & 3, r & 1, tid, lane, wave); }
    }
}

constexpr int N_PHASES = 1 + 7 * NL;
#ifndef REPEAT_KIND
#define REPEAT_KIND -1
#endif
#ifndef PHASE_MASK
#define PHASE_MASK 255
#endif
__global__ void __launch_bounds__(512, 2) fwd_megakernel(Args a) {
    extern __shared__ __attribute__((aligned(16))) unsigned char lds_raw[];
    LAS unsigned char* lds = (LAS unsigned char*)lds_raw;
    unsigned char* ws = a.ws;
    const bool coop = (a.ph_hi - a.ph_lo) > 1;
    XcdBarrier bar; bar.bar = (unsigned*)(ws + WS_BAR); bar.x = 0; bar.st = nullptr;
    if (coop) {
        if (threadIdx.x < 64) ((LAS unsigned*)(lds + 131072))[threadIdx.x] = 0u;
        __syncthreads();
        bar = xcd_barrier_post((unsigned*)(ws + WS_BAR), (volatile LAS unsigned*)(lds + 131072));
        if (a.ph_hi > 100000) cg::this_grid().sync();
    }
    const float* mod = (const float*)(ws + WS_MOD);
    bf16_t* XN = (bf16_t*)(ws + WS_XN); bf16_t* Zb = (bf16_t*)(ws + WS_Z); bf16_t* MIXC = (bf16_t*)(ws + WS_MIXC); bf16_t* HB = (bf16_t*)(ws + WS_HB);
    float* X1 = (float*)(ws + WS_X1); float* X = (float*)(ws + WS_X);
#if REPEAT_KIND >= 0
    const int nsteps = N_PHASES + (REPEAT_KIND == 7 ? 1 : NL);
    for (int step = 0; step < nsteps; ++step) {
        int ph;
        if (REPEAT_KIND == 7) ph = step == 0 ? 0 : step - 1;
        else if (step == 0) ph = 0;
        else { const int s_ = step - 1, l_ = s_ / 8, j_ = s_ % 8; ph = 1 + 7 * l_ + (j_ <= REPEAT_KIND ? j_ : j_ - 1); }
        const bool last_step = step + 1 >= nsteps;
#else
    for (int ph = a.ph_lo; ph < a.ph_hi; ++ph) {
        const bool last_step = ph + 1 >= a.ph_hi;
#endif
        int tid_raw = threadIdx.x; asm volatile("" : "+v"(tid_raw));
        const int tid = tid_raw, lane = tid & 63, wave = __builtin_amdgcn_readfirstlane(tid >> 6);
        if (ph == 0) { if (PHASE_MASK & 128) p0_prologue(a, lds, tid, lane, wave); }
        else {
            const int l = (ph - 1) / 7, k = (ph - 1) % 7;
            const float* modl = mod + (size_t)l * 3 * 6144;
            const float* xin0 = l == 0 ? a.in[0] : X; const float* xin1 = l == 0 ? a.in[1] : X + (size_t)MCTX * 1024;
            if (k == 4 || (k == 0 && l > 0)) continue;
            if (k == 0) { prep_phase(a, lane, wave); }
            else if (k == 1) { if (PHASE_MASK & 2) {
                pg8::Gemm g{XN, (const bf16_t*)(ws + WS_WIN) + (size_t)l * 2304 * 1024, M, NZ, DM}; pg8::StaticOrder S; S.init(M, NZ, gridDim.x, blockIdx.x);
                pg8::EpiG1 E{Zb, a.out + (size_t)M * 1024, a.out + (size_t)M * 1024 + (size_t)32 * 4 * 256 * 256, a.in[11] + l * 32, a.in[12] + l * 32, (const float*)(ws + WS_ROPE), l, (const float*)(ws + WS_RSS1), (const float*)(ws + WS_CV1) + (size_t)l * 3 * 2304, (const LAS float*)(lds + pg8::RSS_LDS_OFF)};
                pg8::gemm_phase<pg8::EpiG1, pg8::StaticOrder, true, true>(lds, g, S, E); }
            }
            else if (k == 2) { if (PHASE_MASK & 4) mix_phase(a, lds, l, tid, lane, wave); }
            else if (k == 3) { if (PHASE_MASK & 8) {
                pg8::Gemm g{MIXC, (const bf16_t*)(ws + WS_WOUT) + (size_t)l * 1024 * 1024, M, DM, DM}; pg8::StaticOrder S; S.init(M, DM, gridDim.x, blockIdx.x);
                pg8::EpiRes E{a.in[0], a.in[1], l == 0 ? nullptr : (const bf16_t*)X, nullptr, (bf16_t*)X1, modl + 2 * 1024, XN, a.in[9] + l * 1024, modl + 4 * 1024, (float*)(ws + WS_RSS2)};
                pg8::gemm_phase<pg8::EpiRes, pg8::StaticOrder, true, true>(lds, g, S, E);
                if (l + 1 < NL && (int)blockIdx.x >= 160 && (int)gridDim.x > 160) weights_layer(a, lds, l + 1, blockIdx.x - 160, gridDim.x - 160, tid, lane, wave); }
            }
            else if (k == 4) { if (PHASE_MASK & 1) norm_phase(X1, X1 + (size_t)MCTX * 1024, a.in[9] + l * 1024, modl, 3, 4, XN, lane, wave); }
            else if (k == 5) { if (PHASE_MASK & 16) {
                pg8::Gemm g{XN, (const bf16_t*)(ws + WS_W1) + (size_t)l * 4096 * 1024, M, FF, DM}; pg8::StaticOrder S; S.init(M, FF, gridDim.x, blockIdx.x);
                pg8::EpiRelu2 E{HB, FF, (const float*)(ws + WS_RSS2), (const float*)(ws + WS_CV2) + (size_t)l * 3 * 4096, (const LAS float*)(lds + pg8::RSS_LDS_OFF)};
                pg8::gemm_phase<pg8::EpiRelu2, pg8::StaticOrder, true, true>(lds, g, S, E);
 }
            }
            else { if (PHASE_MASK & 32) {
                pg8::Gemm g{HB, (const bf16_t*)(ws + WS_W2) + (size_t)l * 1024 * 4096, M, DM, FF}; pg8::StaticOrder S; S.init(M, DM, gridDim.x, blockIdx.x);
                pg8::EpiRes E{nullptr, nullptr, (const bf16_t*)X1, l == NL - 1 ? a.out : nullptr, l == NL - 1 ? nullptr : (bf16_t*)X, modl + 5 * 1024, l == NL - 1 ? nullptr : XN, a.in[8] + (l + 1 < NL ? l + 1 : l) * 1024, modl + 3 * 6144 + 1 * 1024, (float*)(ws + WS_RSS1)};
                pg8::gemm_phase<pg8::EpiRes, pg8::StaticOrder, true, true>(lds, g, S, E);
                if (l + 1 < NL && (int)blockIdx.x >= 160) cvec_layer(a, l + 1, (blockIdx.x - 160) * 8 + wave, (gridDim.x - 160) * 8, lane); }
            }
        }
        if (!last_step) { xcd_barrier(bar); }
    }
}

#ifndef MK_MULTI
#define MK_MULTI 0
#endif
extern "C" void kernel_launch(void* const* d_in, const int* in_sizes, int n_in, void* d_out, int out_size, void* d_ws, size_t ws_size, hipStream_t stream) {
    static int grid = 0;
    if (grid == 0) {
        if (n_in != 29 || ws_size < WS_END || out_size != 27262976) { fprintf(stderr, "kernel_launch: unexpected shapes: n_in %d ws %zu (need %zu) out %d\n", n_in, ws_size, (size_t)WS_END, out_size); grid = -1; return; }
        int dev = 0, cus = 0, per_cu = 0;
        if (hipGetDevice(&dev) != hipSuccess || hipDeviceGetAttribute(&cus, hipDeviceAttributeMultiprocessorCount, dev) != hipSuccess) { grid = -1; return; }
        if (hipFuncSetAttribute((const void*)fwd_megakernel, hipFuncAttributeMaxDynamicSharedMemorySize, LDS_BYTES) != hipSuccess) { fprintf(stderr, "kernel_launch: hipFuncSetAttribute failed\n"); grid = -1; return; }
        if (hipOccupancyMaxActiveBlocksPerMultiprocessor(&per_cu, (const void*)fwd_megakernel, 512, LDS_BYTES) != hipSuccess || per_cu < 1) { fprintf(stderr, "kernel_launch: occupancy query gave %d\n", per_cu); per_cu = 1; }
        (void)hipGetLastError();
        grid = cus * per_cu;
    }
    if (grid < 0) return;
    (void)hipMemsetAsync((char*)d_ws + WS_BAR, 0, WS_MOD + MOD_BYTES, stream);
    Args a{};
    for (int i = 0; i < 29; ++i) a.in[i] = (const float*)d_in[i];
    a.out = (float*)d_out; a.ws = (unsigned char*)d_ws;
#if MK_MULTI
    for (int ph = 0; ph < N_PHASES; ++ph) { a.ph_lo = ph; a.ph_hi = ph + 1; hipLaunchKernelGGL(fwd_megakernel, dim3(grid), dim3(512), LDS_BYTES, stream, a); }
#else
    a.ph_lo = 0; a.ph_hi = N_PHASES;
    void* args[] = {&a};
    hipError_t e = hipLaunchCooperativeKernel((const void*)fwd_megakernel, dim3(grid), dim3(512), args, LDS_BYTES, stream);
    if (e != hipSuccess) fprintf(stderr, "cooperative launch failed: %s (grid %d)\n", hipGetErrorString(e), grid);
#endif
}
```

```cpp
#include <hip/hip_runtime.h>
#include <hip/hip_cooperative_groups.h>
#include <cstdio>
#include <cstdint>
namespace cg = cooperative_groups;
namespace pg8 {
#define PG8_LAS __attribute__((address_space(3)))
typedef unsigned short bf16_t;
typedef short bf16x8 __attribute__((ext_vector_type(8)));
typedef float f32x4 __attribute__((ext_vector_type(4)));
typedef unsigned u32x4 __attribute__((ext_vector_type(4)));
constexpr int RSS_LDS_OFF = 131072 + 256;
constexpr int BM = 256, BK = 64, HALF = 128, HTB = HALF * BK * 2  , STAGE_BYTES = 8 * HTB, NXCD = 8, WGM = 8;

__host__ __device__ __forceinline__ int lds_byte(int r, int c) { const int st = (r >> 4) * 2 + (c >> 5), rr = r & 15, cc = c & 31, ob = rr * 64 + cc * 2; return st * 1024 + (ob ^ (((ob >> 9) & 1) << 5)); }
__host__ __device__ __forceinline__ void stage_rc(int b, int& R, int& C) { const int st = b / 1024, sb = b % 1024, swz = sb ^ (((sb >> 9) & 1) << 5); R = (st >> 1) * 16 + swz / 64; C = (st & 1) * 32 + (swz % 64) / 2; }
__host__ __device__ __forceinline__ int perm32(int rho) { const int n = rho >> 4, i = rho & 15; return 8 * (i >> 2) + 4 * n + (i & 3); }

struct Unit { int pm, pn; };
struct Gemm { const bf16_t* A; const bf16_t* Bt; int M, N, K; };

struct StaticOrder {
    int nM, nN, nwg, G, c;
    int wgm = WGM;
    __host__ __device__ void init(int M, int N, int G_, int c_) { nM = M / BM; nN = N / BM; nwg = nM * nN; G = G_; c = c_; }
    __host__ __device__ bool next(int i, Unit& u) const {
        const long L = (long)i * G + c; if (L >= nwg) return false;
        int wgid = (int)L; { const int q = nwg / NXCD, r = nwg % NXCD, xcd = wgid % NXCD, off = wgid / NXCD; wgid = (xcd < r ? xcd * (q + 1) : r * (q + 1) + (xcd - r) * q) + off; }
        const int nig = wgm * nN, gid = wgid / nig, fm = gid * wgm, gsz = (nM - fm) < wgm ? (nM - fm) : wgm;
        u.pm = fm + ((wgid % nig) % gsz); u.pn = (wgid % nig) / gsz; return true;
    }
    __device__ __forceinline__ void a_ready(const Unit&) const {}
    __device__ __forceinline__ void done(const Unit&) const {}
};

typedef __bf16 bf16v2_t __attribute__((ext_vector_type(2)));
typedef float f32v2_t __attribute__((ext_vector_type(2)));
__device__ __forceinline__ unsigned cvt_pk_bf16(float lo, float hi) { const bf16v2_t r = __builtin_convertvector((f32v2_t){lo, hi}, bf16v2_t); return __builtin_bit_cast(unsigned, r); }
typedef float f32x2 __attribute__((ext_vector_type(2)));
__device__ __forceinline__ float dot4(const f32x4 a) { return (a[0] * a[0] + a[1] * a[1]) + (a[2] * a[2] + a[3] * a[3]); }
__device__ __forceinline__ f32x4 shfl_xor4(const f32x4 v, int m) { f32x4 r; r[0] = __shfl_xor(v[0], m); r[1] = __shfl_xor(v[1], m); r[2] = __shfl_xor(v[2], m); r[3] = __shfl_xor(v[3], m); return r; }
__device__ __forceinline__ float gelu_tanh(float x) { const float t = x * (-2.3022081945f + -0.1029432395f * (x * x)); return x * __builtin_amdgcn_rcpf(1.0f + __builtin_amdgcn_exp2f(t)); }
__device__ __forceinline__ f32x4 gelu4(const f32x4 v) { f32x4 r; r[0] = gelu_tanh(v[0]); r[1] = gelu_tanh(v[1]); r[2] = gelu_tanh(v[2]); r[3] = gelu_tanh(v[3]); return r; }
__device__ __forceinline__ u32x4 pack8(const f32x4 v0, const f32x4 v1) { u32x4 w; w.x = cvt_pk_bf16(v0[0], v0[1]); w.y = cvt_pk_bf16(v0[2], v0[3]); w.z = cvt_pk_bf16(v1[0], v1[1]); w.w = cvt_pk_bf16(v1[2], v1[3]); return w; }

__device__ __forceinline__ float rinv_lds(const PG8_LAS float* rss_lds, int ai, int wr, int m, int fr, int fq) {
    const f32x4 s4 = ((const PG8_LAS f32x4*)rss_lds)[(ai * HALF + wr * 64 + m * 16 + fr) * 4 + fq]; float sr = (s4[0] + s4[1]) + (s4[2] + s4[3]); sr += __shfl_xor(sr, 16); sr += __shfl_xor(sr, 32); return __builtin_amdgcn_rsqf(sr * (1.0f / 1024.0f) + 1e-6f); }
struct EpiG1 {
    static constexpr bool PERM = true, AFTER_DRAIN = false, NEEDS_RSS = true;
    bf16_t* Z; float* outk; float* outv; const float* gq; const float* gk; const float* rope; int layer;
    const float* rss; const float* cvec; const PG8_LAS float* rss_lds;
    __device__ __forceinline__ void operator()(const f32x4 (&acc)[2][2][4][2], const Unit& u, int wr, int wc, int fr, int fq) const {
        const int pn = u.pn, pm = u.pm;
        const int row0 = pm * BM + wr * 64 + fr;
        const bool latent = pm >= 32;
        const int colw = wc * 32 + 8 * fq;
        f32x4 cb[2][2];
        { const float* cp = cvec + (pm < 32 ? 0 : 1 + ((pm - 32) >> 2)) * 2304 + pn * 256 + colw;
#pragma unroll
          for (int bj = 0; bj < 2; ++bj) { cb[bj][0] = *(const f32x4*)(cp + bj * HALF); cb[bj][1] = *(const f32x4*)(cp + bj * HALF + 4); } }
        if (pn <= 1) {
            const float* gsrc = pn == 0 ? gq : gk;
            const f32x4 g0 = *(const f32x4*)(gsrc + 8 * fq), g1 = *(const f32x4*)(gsrc + 8 * fq + 4);
            const float qscale = pn == 0 ? (0.17677669529663687f * 1.4426950408889634f) : 1.0f;
            const float sgn = (fq & 1) ? 1.0f : -1.0f;
#pragma unroll
            for (int ai = 0; ai < 2; ++ai)
#pragma unroll
                for (int m = 0; m < 4; ++m) {
                    const int r = row0 + ai * HALF + m * 16; const float rv = rinv_lds(rss_lds, ai, wr, m, fr, fq);
                    f32x4 c0 = {1.f, 1.f, 1.f, 1.f}, c1 = c0, s0 = {0.f, 0.f, 0.f, 0.f}, s1 = s0;
                    if (latent) { const int t = (r - 8192) & 1023; const int pos = (fq >> 1) ? (t & 63) : (t >> 6); const float* rp = rope + pos * 16;
                        c0 = *(const f32x4*)(rp); c1 = *(const f32x4*)(rp + 4); s0 = *(const f32x4*)(rp + 8); s1 = *(const f32x4*)(rp + 12); }
#pragma unroll
                    for (int bj = 0; bj < 2; ++bj) {
                        f32x4 v0 = acc[ai][bj][m][0] * rv + cb[bj][0], v1 = acc[ai][bj][m][1] * rv + cb[bj][1];
                        float ss = dot4(v0) + dot4(v1);
                        ss += __shfl_xor(ss, 16); ss += __shfl_xor(ss, 32);
                        const float rinv = __builtin_amdgcn_rsqf(ss * (1.0f / 32.0f) + 1e-6f);
                        v0 = v0 * rinv * g0; v1 = v1 * rinv * g1;
                        if (pn == 1 && !latent) { float* o = outk + ((size_t)((r >> 8) * 4 + layer) * 256 + (r & 255)) * 256 + bj * HALF + colw; *(f32x4*)o = v0; *(f32x4*)(o + 4) = v1; }
                        if (latent) { const f32x4 p0 = shfl_xor4(v0, 16), p1 = shfl_xor4(v1, 16); v0 = v0 * c0 + (p0 * s0) * sgn; v1 = v1 * c1 + (p1 * s1) * sgn; }
                        v0 = v0 * qscale; v1 = v1 * qscale;
                        *(u32x4*)(Z + (size_t)r * 2304 + pn * 256 + bj * HALF + colw) = pack8(v0, v1);
                    }
                }
        } else {
#pragma unroll
            for (int ai = 0; ai < 2; ++ai)
#pragma unroll
                for (int m = 0; m < 4; ++m) {
                    const int r = row0 + ai * HALF + m * 16; const float rv = rinv_lds(rss_lds, ai, wr, m, fr, fq);
#pragma unroll
                    for (int bj = 0; bj < 2; ++bj) {
                        f32x4 v0 = acc[ai][bj][m][0] * rv + cb[bj][0], v1 = acc[ai][bj][m][1] * rv + cb[bj][1];
                        if (pn == 2 && !latent) { float* o = outv + ((size_t)((r >> 8) * 4 + layer) * 256 + (r & 255)) * 256 + bj * HALF + colw; *(f32x4*)o = v0; *(f32x4*)(o + 4) = v1; }
                        if (pn == 3 || pn == 4) { v0 = gelu4(v0); v1 = gelu4(v1); }
                        *(u32x4*)(Z + (size_t)r * 2304 + pn * 256 + bj * HALF + colw) = pack8(v0, v1);
                    }
                }
        }
    }
};
struct EpiRes {
    static constexpr bool PERM = true, AFTER_DRAIN = false, NEEDS_RSS = false;
    const float* base0; const float* base1;
    const bf16_t* baseh;
    float* outf; bf16_t* outh;
    const float* gate;
    bf16_t* an; const float* gnorm; const float* scv; float* rss_out;
    __device__ __forceinline__ void operator()(const f32x4 (&acc)[2][2][4][2], const Unit& u, int wr, int wc, int fr, int fq) const {
        const int pm = u.pm; const int cond = pm < 32 ? 0 : 1 + ((pm - 32) >> 2);
        const int col0 = u.pn * BM + wc * 32 + 8 * fq;
        const float* gp = gate + cond * 6144 + col0;
        f32x4 gv[2][2];
#pragma unroll
        for (int bj = 0; bj < 2; ++bj)
#pragma unroll
            for (int n = 0; n < 2; ++n) gv[bj][n] = *(const f32x4*)(gp + bj * HALF + n * 4);
        const size_t rowbase = (size_t)(pm * BM) * 1024;
        const float* bs = pm < 32 ? base0 + rowbase : base1 + (rowbase - (size_t)8192 * 1024);
        f32x4 gs[2][2];
        if (an) {
#pragma unroll
            for (int bj = 0; bj < 2; ++bj)
#pragma unroll
                for (int n = 0; n < 2; ++n) gs[bj][n] = *(const f32x4*)(gnorm + col0 + bj * HALF + n * 4) * (*(const f32x4*)(scv + cond * 6144 + col0 + bj * HALF + n * 4) + 1.0f);
        }
#pragma unroll
        for (int ai = 0; ai < 2; ++ai)
#pragma unroll
            for (int m = 0; m < 4; ++m) { const size_t off = (size_t)(ai * HALF + wr * 64 + m * 16 + fr) * 1024 + col0; float ssq = 0.f;
#pragma unroll
                for (int bj = 0; bj < 2; ++bj) { const size_t o2 = off + bj * HALF; f32x4 b0, b1;
                    if (baseh) { const u32x4 w = *(const u32x4*)(baseh + rowbase + o2);
                        b0 = (f32x4){__uint_as_float(w.x << 16), __uint_as_float(w.x & 0xffff0000u), __uint_as_float(w.y << 16), __uint_as_float(w.y & 0xffff0000u)};
                        b1 = (f32x4){__uint_as_float(w.z << 16), __uint_as_float(w.z & 0xffff0000u), __uint_as_float(w.w << 16), __uint_as_float(w.w & 0xffff0000u)}; }
                    else { b0 = *(const f32x4*)(bs + o2); b1 = *(const f32x4*)(bs + o2 + 4); }
                    const f32x4 x0 = b0 + gv[bj][0] * acc[ai][bj][m][0], x1 = b1 + gv[bj][1] * acc[ai][bj][m][1];
                    if (outh) *(u32x4*)(outh + rowbase + o2) = pack8(x0, x1); else { *(f32x4*)(outf + rowbase + o2) = x0; *(f32x4*)(outf + rowbase + o2 + 4) = x1; }
                    if (an) { ssq += dot4(x0) + dot4(x1); *(u32x4*)(an + rowbase + o2) = pack8(x0 * gs[bj][0], x1 * gs[bj][1]); } }
                if (an) { ssq += __shfl_xor(ssq, 16); ssq += __shfl_xor(ssq, 32); if (fq == 0) rss_out[(size_t)(pm * BM + ai * HALF + wr * 64 + m * 16 + fr) * 16 + u.pn * 4 + wc] = ssq; } }
    }
};
struct EpiRelu2 {
    static constexpr bool PERM = true, AFTER_DRAIN = false, NEEDS_RSS = true;
    bf16_t* O; int ldc; const float* rss; const float* cvec; const PG8_LAS float* rss_lds;
    __device__ __forceinline__ void operator()(const f32x4 (&acc)[2][2][4][2], const Unit& u, int wr, int wc, int fr, int fq) const {
        const int row0 = u.pm * BM + wr * 64 + fr; const int col0 = u.pn * BM + wc * 32 + 8 * fq;
        f32x4 cb[2][2];
        { const float* cp = cvec + (u.pm < 32 ? 0 : 1 + ((u.pm - 32) >> 2)) * ldc + col0;
#pragma unroll
          for (int bj = 0; bj < 2; ++bj) { cb[bj][0] = *(const f32x4*)(cp + bj * HALF); cb[bj][1] = *(const f32x4*)(cp + bj * HALF + 4); } }
#pragma unroll
        for (int ai = 0; ai < 2; ++ai)
#pragma unroll
            for (int m = 0; m < 4; ++m) { bf16_t* rowp = O + (size_t)(row0 + ai * HALF + m * 16) * ldc + col0; const float rv = rinv_lds(rss_lds, ai, wr, m, fr, fq);
#pragma unroll
                for (int bj = 0; bj < 2; ++bj) { f32x4 v0 = acc[ai][bj][m][0] * rv + cb[bj][0], v1 = acc[ai][bj][m][1] * rv + cb[bj][1];
                    v0 = __builtin_elementwise_max(v0, (f32x4){0.f, 0.f, 0.f, 0.f}); v1 = __builtin_elementwise_max(v1, (f32x4){0.f, 0.f, 0.f, 0.f});
                    v0 = v0 * v0; v1 = v1 * v1; *(u32x4*)(rowp + bj * HALF) = pack8(v0, v1); } }
    }
};

template <class Epi, class Sched, bool ALIGN_EPI = false, bool SP2 = false>
__device__ __forceinline__ void gemm_phase(PG8_LAS unsigned char* lds, const Gemm g, const Sched& S, const Epi& E) {
    int tid_raw = threadIdx.x; asm volatile("" : "+v"(tid_raw));
    const int tid = tid_raw, wid = __builtin_amdgcn_readfirstlane(tid >> 6), lane = tid & 63, wr = wid >> 2, wc = wid & 3, fr = lane & 15, fq = lane >> 4;
    const int K = g.K, nt = K / BK;
    unsigned voffA[2], voffB[2];
#pragma unroll
    for (int i = 0; i < 2; ++i) { int R, C; stage_rc(tid * 16 + i * 8192, R, C); const int Rb = Epi::PERM ? ((R & ~31) + perm32(R & 31)) : R;
        voffA[i] = (unsigned)(R * K + C) * 2u; voffB[i] = (unsigned)(Rb * K + C) * 2u; }
    const size_t kstep = (size_t)(BK * 2);
    const size_t hstep = (size_t)HALF * K * 2;
    const size_t tstep = 2 * hstep;
    const unsigned ldsw = (unsigned)wid * 1024u;
    const int aoff = lds_byte(wr * 64 + fr, fq * 8), boff = lds_byte(wc * 32 + fr, fq * 8);
#define PG8_SA(b, h) (((b) * 2 + (h)) * HTB)
#define PG8_SB(b, h) ((4 + (b) * 2 + (h)) * HTB)
#define PG8_STAGE(bufoff, gbase, voff) do { _Pragma("unroll") for (int _i = 0; _i < 2; ++_i) \
        __builtin_amdgcn_global_load_lds((const unsigned*)((const char*)(gbase) + (voff)[_i]), (PG8_LAS unsigned*)(lds + (bufoff) + ldsw + _i * 8192), 16, 0, 0); } while (0)
#define PG8_LDA(dst, b, h) do { _Pragma("unroll") for (int m = 0; m < 4; ++m) _Pragma("unroll") for (int k = 0; k < 2; ++k) dst[m][k] = *(const PG8_LAS bf16x8*)(lds + PG8_SA(b, h) + aoff + m * 2048 + k * 1024); } while (0)
#define PG8_LDB(dst, b, h) do { _Pragma("unroll") for (int n = 0; n < 2; ++n) _Pragma("unroll") for (int k = 0; k < 2; ++k) dst[n][k] = *(const PG8_LAS bf16x8*)(lds + PG8_SB(b, h) + boff + n * 2048 + k * 1024); } while (0)
#define PG8_MMA(ai, bj, At, Bt) do { __builtin_amdgcn_s_setprio(1); _Pragma("unroll") for (int m = 0; m < 4; ++m) _Pragma("unroll") for (int n = 0; n < 2; ++n) _Pragma("unroll") for (int k = 0; k < 2; ++k) \
        acc[ai][bj][m][n] = __builtin_amdgcn_mfma_f32_16x16x32_bf16(Bt[n][k], At[m][k], acc[ai][bj][m][n], 0, 0, 0); __builtin_amdgcn_s_setprio(0); } while (0)
#define PG8_WAIT_V(n) asm volatile("s_waitcnt vmcnt(" #n ")" ::: "memory")
#define PG8_WAIT_L(n) asm volatile("s_waitcnt lgkmcnt(" #n ")" ::: "memory")
#define PG8_BAR __builtin_amdgcn_s_barrier()
#define PG8_SCHED __builtin_amdgcn_sched_barrier(0)
    Unit cur, nxt; int ui = 0;
    if (!S.next(0, cur)) return;
#define PG8_RSS_DMA(unit) do { const char* rsrc_ = (const char*)E.rss + (size_t)(unit).pm * (BM * 64) + (size_t)tid * 16; \
        _Pragma("unroll") for (int _i = 0; _i < 2; ++_i) __builtin_amdgcn_global_load_lds((const unsigned*)(rsrc_ + _i * 8192), (PG8_LAS unsigned*)(lds + RSS_LDS_OFF + ldsw + _i * 8192), 16, 0, 0); } while (0)
    if constexpr (Epi::NEEDS_RSS) { static_assert(ALIGN_EPI, "the row-statistics panel hand-over relies on the aligned epilogues"); PG8_RSS_DMA(cur); }
    f32x4 acc[2][2][4][2];
#pragma unroll
    for (int a = 0; a < 2; ++a)
#pragma unroll
        for (int b = 0; b < 2; ++b)
#pragma unroll
            for (int m = 0; m < 4; ++m)
#pragma unroll
                for (int n = 0; n < 2; ++n) acc[a][b][m][n] = (f32x4){0.f, 0.f, 0.f, 0.f};
    bf16x8 At[4][2], B0[2][2], B1[2][2];
    const char* cA = (const char*)g.A + (size_t)cur.pm * tstep; const char* cB = (const char*)g.Bt + (size_t)cur.pn * tstep;
    S.a_ready(cur);
    if constexpr (SP2) {
        PG8_STAGE(PG8_SB(0, 0), cB, voffB); PG8_STAGE(PG8_SB(0, 1), cB + hstep, voffB); PG8_STAGE(PG8_SA(0, 0), cA, voffA); PG8_STAGE(PG8_SA(0, 1), cA + hstep, voffA);
        if (wr == 1) PG8_BAR;
        PG8_WAIT_V(2); PG8_BAR;
        PG8_STAGE(PG8_SB(1, 0), cB + kstep, voffB); PG8_STAGE(PG8_SA(1, 0), cA + kstep, voffA); PG8_STAGE(PG8_SB(1, 1), cB + hstep + kstep, voffB);
        PG8_WAIT_V(6); PG8_BAR;
    } else {
        PG8_STAGE(PG8_SB(0, 0), cB, voffB); PG8_STAGE(PG8_SA(0, 0), cA, voffA); PG8_STAGE(PG8_SB(0, 1), cB + hstep, voffB); PG8_STAGE(PG8_SA(0, 1), cA + hstep, voffA);
        if (wr == 1) PG8_BAR;
        PG8_WAIT_V(4); PG8_BAR;
        PG8_STAGE(PG8_SB(1, 0), cB + kstep, voffB); PG8_STAGE(PG8_SA(1, 0), cA + kstep, voffA); PG8_STAGE(PG8_SB(1, 1), cB + hstep + kstep, voffB);
        PG8_WAIT_V(6); PG8_BAR;
    }
    for (;;) {
        const bool has_next = S.next(ui + 1, nxt);
        const char* nA = has_next ? (const char*)g.A + (size_t)nxt.pm * tstep : cA; const char* nB = has_next ? (const char*)g.Bt + (size_t)nxt.pn * tstep : cB;
        for (int t = 0; t < nt; t += 2) {
            const bool last = (t == nt - 2);
            const char* a1 = cA + (size_t)(t + 1) * kstep;
            const char* a2 = last ? nA : cA + (size_t)(t + 2) * kstep; const char* b2 = last ? nB : cB + (size_t)(t + 2) * kstep;
            const char* a3 = a2 + kstep; const char* b3 = b2 + kstep;
            if (last && has_next) S.a_ready(nxt);
            if constexpr (SP2) {
            PG8_LDB(B0, 0, 0); PG8_LDB(B1, 0, 1); PG8_SCHED; PG8_LDA(At, 0, 0); PG8_STAGE(PG8_SA(1, 1), a1 + hstep, voffA);
            PG8_WAIT_V(8); PG8_WAIT_L(0); PG8_BAR;
            PG8_MMA(0, 0, At, B0); PG8_MMA(0, 1, At, B1); PG8_BAR; PG8_SCHED;
            PG8_LDA(At, 0, 1); PG8_STAGE(PG8_SB(0, 0), b2, voffB); PG8_STAGE(PG8_SB(0, 1), b2 + hstep, voffB); PG8_STAGE(PG8_SA(0, 0), a2, voffA);
            PG8_WAIT_V(8); PG8_WAIT_L(0); PG8_BAR; PG8_MMA(1, 0, At, B0); PG8_MMA(1, 1, At, B1); PG8_BAR; PG8_SCHED;
            PG8_LDB(B0, 1, 0); PG8_LDB(B1, 1, 1); PG8_SCHED; PG8_LDA(At, 1, 0); PG8_STAGE(PG8_SA(0, 1), a2 + hstep, voffA);
            PG8_WAIT_V(8); PG8_WAIT_L(0); PG8_BAR; PG8_MMA(0, 0, At, B0); PG8_MMA(0, 1, At, B1); PG8_BAR; PG8_SCHED;
            PG8_LDA(At, 1, 1); PG8_STAGE(PG8_SB(1, 0), b3, voffB); PG8_STAGE(PG8_SB(1, 1), b3 + hstep, voffB); PG8_STAGE(PG8_SA(1, 0), a3, voffA);
            PG8_WAIT_V(8); PG8_WAIT_L(0); PG8_BAR; PG8_MMA(1, 0, At, B0); PG8_MMA(1, 1, At, B1); PG8_BAR; PG8_SCHED;
            } else {
            PG8_LDB(B0, 0, 0); PG8_SCHED; PG8_LDA(At, 0, 0); PG8_STAGE(PG8_SA(1, 1), a1 + hstep, voffA);
            PG8_WAIT_L(8); PG8_BAR; PG8_WAIT_L(0); PG8_MMA(0, 0, At, B0); PG8_BAR; PG8_SCHED;
            PG8_LDB(B1, 0, 1); PG8_STAGE(PG8_SB(0, 0), b2, voffB);
            PG8_BAR; PG8_WAIT_L(0); PG8_MMA(0, 1, At, B1); PG8_BAR;
            PG8_LDA(At, 0, 1); PG8_STAGE(PG8_SA(0, 0), a2, voffA);
            PG8_BAR; PG8_WAIT_L(0); PG8_MMA(1, 0, At, B0); PG8_BAR; PG8_SCHED;
            PG8_STAGE(PG8_SB(0, 1), b2 + hstep, voffB);
            PG8_WAIT_V(6); PG8_BAR; PG8_MMA(1, 1, At, B1); PG8_BAR;
            PG8_LDB(B0, 1, 0); PG8_SCHED; PG8_LDA(At, 1, 0); PG8_STAGE(PG8_SA(0, 1), a2 + hstep, voffA);
            PG8_WAIT_L(8); PG8_BAR; PG8_WAIT_L(0); PG8_MMA(0, 0, At, B0); PG8_BAR; PG8_SCHED;
            PG8_LDB(B1, 1, 1); PG8_STAGE(PG8_SB(1, 0), b3, voffB);
            PG8_BAR; PG8_WAIT_L(0); PG8_MMA(0, 1, At, B1); PG8_BAR;
            PG8_LDA(At, 1, 1); PG8_STAGE(PG8_SA(1, 0), a3, voffA);
            PG8_BAR; PG8_WAIT_L(0); PG8_MMA(1, 0, At, B0); PG8_BAR; PG8_SCHED;
            PG8_STAGE(PG8_SB(1, 1), b3 + hstep, voffB);
            PG8_WAIT_V(6); PG8_BAR; PG8_MMA(1, 1, At, B1); PG8_BAR;
            }
        }
        if constexpr (ALIGN_EPI) { if (wr == 0) PG8_BAR; }
        if constexpr (!Epi::AFTER_DRAIN) { E(acc, cur, wr, wc, fr, fq); S.done(cur); }
        if (!has_next) break;
#pragma unroll
        for (int a = 0; a < 2; ++a)
#pragma unroll
            for (int b = 0; b < 2; ++b)
#pragma unroll
                for (int m = 0; m < 4; ++m)
#pragma unroll
                    for (int n = 0; n < 2; ++n) acc[a][b][m][n] = (f32x4){0.f, 0.f, 0.f, 0.f};
        cur = nxt; cA = nA; cB = nB; ++ui;
        if constexpr (Epi::NEEDS_RSS) { PG8_BAR; PG8_RSS_DMA(cur); }
        if constexpr (ALIGN_EPI) { if (wr == 1) PG8_BAR; }
    }
    PG8_WAIT_V(0);
    if constexpr (!ALIGN_EPI) { if (wr == 0) PG8_BAR; }
    PG8_BAR;
    if constexpr (Epi::AFTER_DRAIN) { E.fused(acc, cur, wr, wc, fr, fq, lds, wid, lane); S.done(cur); }
#undef PG8_RSS_DMA
#undef PG8_SA
#undef PG8_SB
#undef PG8_STAGE
#undef PG8_LDA
#undef PG8_LDB
#undef PG8_MMA
#undef PG8_WAIT_V
#undef PG8_WAIT_L
#undef PG8_BAR
#undef PG8_SCHED
}
}
#define LAS __attribute__((address_space(3)))
typedef unsigned short bf16_t;
typedef unsigned v4u __attribute__((ext_vector_type(4)));
typedef unsigned v2u __attribute__((ext_vector_type(2)));
typedef float f32x4 __attribute__((ext_vector_type(4)));
typedef short bf16x8 __attribute__((ext_vector_type(8)));
#define MFMA16(a, b, c) __builtin_amdgcn_mfma_f32_16x16x32_bf16((a), (b), (c), 0, 0, 0)
#define LDS_WAIT() asm volatile("s_waitcnt lgkmcnt(0)" ::: "memory")

constexpr int M = 10240, DM = 1024, NZ = 2304, FF = 4096, NL = 4, MCTX = 8192;
constexpr int LDS_BYTES = 131072 + 256 + 16384;
constexpr size_t al256(size_t x) { return (x + 255) & ~(size_t)255; }
constexpr size_t WS_BAR = 0;
constexpr size_t WS_MOD = 16384;
constexpr size_t MOD_BYTES = (size_t)4 * 3 * 6144 * 4;
constexpr size_t WS_ROPE = al256(WS_MOD + MOD_BYTES);
constexpr size_t WS_T256 = al256(WS_ROPE + 64 * 16 * 4);
constexpr size_t WS_T1024 = al256(WS_T256 + (size_t)256 * 512 * 2);
constexpr size_t WS_KC = al256(WS_T1024 + (size_t)1024 * 2048 * 2);
constexpr size_t WS_VC = al256(WS_KC + (size_t)2 * 4 * 256 * 256 * 2);
constexpr size_t WS_WSP = al256(WS_VC + (size_t)2 * 4 * 256 * 256 * 2);
constexpr size_t WS_WIN = al256(WS_WSP + (size_t)4 * 4 * 128 * 128 * 2);
constexpr size_t WS_WOUT = al256(WS_WIN + (size_t)4 * 2304 * 1024 * 2);
constexpr size_t WS_W1 = al256(WS_WOUT + (size_t)4 * 1024 * 1024 * 2);
constexpr size_t WS_W2 = al256(WS_W1 + (size_t)4 * 4096 * 1024 * 2);
constexpr size_t WS_XN = al256(WS_W2 + (size_t)4 * 4096 * 1024 * 2);
constexpr size_t WS_Z = al256(WS_XN + (size_t)M * 1024 * 2);
constexpr size_t WS_MIXC = al256(WS_Z + (size_t)M * 2304 * 2);
constexpr size_t WS_X1 = al256(WS_MIXC + (size_t)M * 1024 * 2);
constexpr size_t WS_X = al256(WS_X1 + (size_t)M * 1024 * 4);
constexpr size_t WS_HB = al256(WS_X + (size_t)M * 1024 * 4);
constexpr size_t WS_RSS1 = al256(WS_HB + (size_t)M * 4096 * 2);
constexpr size_t WS_RSS2 = al256(WS_RSS1 + (size_t)M * 16 * 4);
constexpr size_t WS_CV1 = al256(WS_RSS2 + (size_t)M * 16 * 4);
constexpr size_t WS_CV2 = al256(WS_CV1 + (size_t)4 * 3 * 2304 * 4);
constexpr size_t WS_END = al256(WS_CV2 + (size_t)4 * 3 * 4096 * 4);

struct Args { const float* in[29]; float* out; unsigned char* ws; int ph_lo, ph_hi; };
static_assert(sizeof(Args) == 29 * 8 + 8 + 8 + 8, "Args has no padding");

__device__ __forceinline__ unsigned f2bf(float f) { unsigned u = __float_as_uint(f); return (u + 0x7fffu + ((u >> 16) & 1u)) >> 16; }
__device__ __forceinline__ unsigned pk2(float lo, float hi) { return pg8::cvt_pk_bf16(lo, hi); }
__device__ __forceinline__ float bflo(unsigned w) { return __uint_as_float(w << 16); }
__device__ __forceinline__ float bfhi(unsigned w) { return __uint_as_float(w & 0xffff0000u); }
__device__ __forceinline__ float bf2f(bf16_t b) { return __uint_as_float((unsigned)b << 16); }
__device__ __forceinline__ float wave_sum(float v) {
#pragma unroll
    for (int o = 1; o < 64; o <<= 1) v += __shfl_xor(v, o);
    return v;
}
__device__ __forceinline__ float sigmoidf_(float x) { return __builtin_amdgcn_rcpf(1.0f + __builtin_amdgcn_exp2f(-1.4426950408889634f * x)); }

#define RLX_AGENT __ATOMIC_RELAXED, __HIP_MEMORY_SCOPE_AGENT
#define XB_TMO      128
#define XB_XCNT(j)  (256  + 64 * (j))
#define XB_XSUB(j)  (1280 + 64 * (j))
#define XB_XGEN(j)  (2304 + 64 * (j))
#define XB_TOP      3328
#define XB_TOPGEN   3392
#define XCD_BAR_WORDS 3456
#define XB_SPIN_CAP (1u << 18)

__device__ __forceinline__ unsigned xb_ld(unsigned* p)              { return __hip_atomic_load(p, __ATOMIC_RELAXED, __HIP_MEMORY_SCOPE_AGENT); }
__device__ __forceinline__ unsigned xb_add(unsigned* p, unsigned v) { return __hip_atomic_fetch_add(p, v, __ATOMIC_RELAXED, __HIP_MEMORY_SCOPE_AGENT); }
__device__ __forceinline__ unsigned xb_xcc_id() { return (unsigned)__builtin_amdgcn_s_getreg((3 << 11) | 20) & 0xFu; }
#define XB_SPIN(cond, bar) do { unsigned _sp = 0; while (cond) { __builtin_amdgcn_s_sleep(1); \
    if ((++_sp & 255u) == 0u) { if (xb_ld(&(bar)[XB_TMO])) break; if (_sp > XB_SPIN_CAP) { atomicAdd(&(bar)[XB_TMO], 1u); break; } } } } while (0)

struct XcdBarrier {
    unsigned* bar; unsigned x;
    volatile LAS unsigned* st;
};

__device__ __forceinline__ XcdBarrier xcd_barrier_post(unsigned* bar, volatile LAS unsigned* st) {
    XcdBarrier b; b.bar = bar; b.x = xb_xcc_id(); b.st = st;
    if (threadIdx.x == 0) (void)xb_add(&bar[XB_XCNT(b.x)], 1u);
    return b;
}
__device__ __forceinline__ void xcd_barrier_complete(unsigned* bar, unsigned x, unsigned& nloc, unsigned& nx) {
    const unsigned G = gridDim.x * gridDim.y * gridDim.z;
    unsigned sum, cnt, mine, sp = 0u;
    for (;;) {
        sum = 0u; cnt = 0u; mine = 0u;
#pragma unroll
        for (unsigned j = 0; j < 16; ++j) { const unsigned c = xb_ld(&bar[XB_XCNT(j)]); sum += c; cnt += (c > 0u) ? 1u : 0u; mine = (j == x) ? c : mine; }
        if (sum == G) break;
        __builtin_amdgcn_s_sleep(1);
        if ((++sp & 255u) == 0u) { if (xb_ld(&bar[XB_TMO])) break; if (sp > XB_SPIN_CAP) { atomicAdd(&bar[XB_TMO], 1u); break; } }
    }
    nloc = mine > 0u ? mine : 1u; nx = cnt > 0u ? cnt : 1u;
}

__device__ __forceinline__ void xcd_barrier(const XcdBarrier& b) {
    asm volatile("s_waitcnt vmcnt(0)" ::: "memory");
    __syncthreads();
    if (threadIdx.x == 0) {
        unsigned* bar = b.bar;
        __builtin_amdgcn_s_waitcnt(0);
        unsigned nloc = b.st[0], nx = b.st[1];
        if (nloc == 0u) { xcd_barrier_complete(bar, b.x, nloc, nx); b.st[0] = nloc; b.st[1] = nx; }
        const unsigned old = xb_add(&bar[XB_XSUB(b.x)], 1u);
        const unsigned gen = old / nloc;
        if (old + 1u == (gen + 1u) * nloc) {
            __builtin_amdgcn_fence(__ATOMIC_RELEASE, "agent");
            asm volatile("s_waitcnt vmcnt(0)" ::: "memory");
            const unsigned og = xb_add(&bar[XB_TOP], 1u);
            const unsigned tg = og / nx;
            if (og + 1u == (tg + 1u) * nx) xb_add(&bar[XB_TOPGEN], 1u);
            else XB_SPIN(xb_ld(&bar[XB_TOPGEN]) == tg, bar);
            __builtin_amdgcn_fence(__ATOMIC_ACQUIRE, "agent");
            xb_add(&bar[XB_XGEN(b.x)], 1u);
            asm volatile("s_waitcnt vmcnt(0)" ::: "memory");
        } else {
            __builtin_amdgcn_fence(__ATOMIC_ACQUIRE, "agent");
            XB_SPIN(xb_ld(&bar[XB_XGEN(b.x)]) == gen, bar);
            asm volatile("s_waitcnt vmcnt(0)" ::: "memory");
        }
    }
    __syncthreads();
}

__device__ __forceinline__ void transpose_item(const float* W, int K, int ldw, int nblk, bf16_t* WT, LAS float* scr, int item, int lane) {
    const int kb = item / nblk, nb = item % nblk, k0 = 64 * kb, n0 = 32 * nb;
    float wv[32];
#pragma unroll
    for (int i = 0; i < 32; ++i) wv[i] = W[(size_t)(k0 + 2 * i + (lane >> 5)) * ldw + n0 + (lane & 31)];
#pragma unroll
    for (int i = 0; i < 32; ++i) scr[(2 * i + (lane >> 5)) * 33 + (lane & 31)] = wv[i];
    LDS_WAIT(); asm volatile("" ::: "memory");
    const int c = lane & 7;
#pragma unroll
    for (int j = 0; j < 4; ++j) { const int n = (lane >> 3) + 8 * j; const LAS float* s = scr + (8 * c) * 33 + n;
        v4u o; o.x = pk2(s[0 * 33], s[1 * 33]); o.y = pk2(s[2 * 33], s[3 * 33]); o.z = pk2(s[4 * 33], s[5 * 33]); o.w = pk2(s[6 * 33], s[7 * 33]);
        *(v4u*)(WT + (size_t)(n0 + n) * K + k0 + 8 * c) = o; }
    LDS_WAIT(); asm volatile("" ::: "memory");
}

__device__ __forceinline__ void weights_layer(const Args& a, LAS unsigned char* lds, int l, int vb, int NB, int tid, int lane, int wave) {
    unsigned char* ws = a.ws;
    const int gw = vb * 8 + wave, NGW = NB * 8;
    LAS float* scr = (LAS float*)(lds + wave * 16384);
    const float* w_in = a.in[10] + (size_t)l * 1024 * 2048; const float* w_out = a.in[26] + (size_t)l * 1024 * 1024; const float* w_ff1 = a.in[27] + (size_t)l * 1024 * 4096; const float* w_ff2 = a.in[28] + (size_t)l * 4096 * 1024;
    bf16_t* WinT = (bf16_t*)(ws + WS_WIN) + (size_t)l * 2304 * 1024; bf16_t* WoutT = (bf16_t*)(ws + WS_WOUT) + (size_t)l * 1024 * 1024; bf16_t* W1T = (bf16_t*)(ws + WS_W1) + (size_t)l * 4096 * 1024; bf16_t* W2T = (bf16_t*)(ws + WS_W2) + (size_t)l * 1024 * 4096;
    constexpr int I_IN = 16 * 56, I_OUT = 16 * 32, I_F1 = 16 * 128, I_F2 = 64 * 32, I_L = I_IN + I_OUT + I_F1 + I_F2;
    for (int it = gw; it < I_L; it += NGW) {
        int r = it;
        if (r < I_IN) { transpose_item(w_in, 1024, 2048, 56, WinT, scr, r, lane); continue; } r -= I_IN;
        if (r < I_OUT) { transpose_item(w_out, 1024, 1024, 32, WoutT, scr, r, lane); continue; } r -= I_OUT;
        if (r < I_F1) { transpose_item(w_ff1, 1024, 4096, 128, W1T, scr, r, lane); continue; } r -= I_F1;
        transpose_item(w_ff2, 4096, 1024, 32, W2T, scr, r, lane);
    }
    __syncthreads();
    for (int it = vb; it < 128; it += NB) {
        const int g = (it >> 5) & 3, kb = it & 31, k0 = kb * 32;
        LAS float* wt = (LAS float*)lds; LAS float* tw = wt + 2048;
        *(LAS f32x4*)(wt + tid * 4) = *(const f32x4*)(w_in + ((size_t)k0 + (tid >> 4)) * 2048 + 1792 + g * 64 + (tid & 15) * 4);
        if (tid < 64) { tw[tid] = __builtin_amdgcn_cosf((float)tid * (1.0f / 64.0f)); tw[64 + tid] = __builtin_amdgcn_sinf((float)tid * (1.0f / 64.0f)); }
        __syncthreads();
        const int m = tid & 63, cs = (tid >> 6) & 1, kq = tid >> 7;
        float o[8];
#pragma unroll
        for (int kk = 0; kk < 8; ++kk) o[kk] = 0.f;
        for (int c = 0; c < 64; ++c) { const float t = tw[cs * 64 + ((m * c) & 63)];
#pragma unroll
            for (int kk = 0; kk < 8; ++kk) o[kk] += wt[(kq * 8 + kk) * 64 + c] * t; }
        v4u pk; pk.x = pk2(o[0], o[1]); pk.y = pk2(o[2], o[3]); pk.z = pk2(o[4], o[5]); pk.w = pk2(o[6], o[7]);
        *(v4u*)(WinT + ((size_t)1792 + cs * 256 + g * 64 + m) * 1024 + k0 + kq * 8) = pk;
        __syncthreads();
    }
}

__device__ __forceinline__ void mod_items(const Args& a, int l_lo, int l_hi, int vw, int NW, int lane) {
    float* mod = (float*)(a.ws + WS_MOD);
    for (int it = l_lo * 384 + vw; it < l_hi * 384; it += NW) {
        const int l = it / 384, cb = it % 384;
        const int ks = lane >> 2, col = cb * 16 + (lane & 3) * 4;
        f32x4 a0 = {0.f, 0.f, 0.f, 0.f}, a1 = a0, a2 = a0;
        const float* wp = a.in[6] + ((size_t)l * 1024 + ks) * 6144 + col;
#pragma unroll 32
        for (int kk = 0; kk < 64; ++kk) { const int k = kk * 16 + ks; const f32x4 w = *(const f32x4*)(wp + (size_t)kk * 16 * 6144);
            const float x0 = a.in[5][k], x1 = a.in[2][k], x2 = a.in[2][1024 + k];
            a0 += w * (x0 * sigmoidf_(x0)); a1 += w * (x1 * sigmoidf_(x1)); a2 += w * (x2 * sigmoidf_(x2)); }
#pragma unroll
        for (int o = 4; o < 64; o <<= 1)
#pragma unroll
            for (int j = 0; j < 4; ++j) { a0[j] += __shfl_xor(a0[j], o); a1[j] += __shfl_xor(a1[j], o); a2[j] += __shfl_xor(a2[j], o); }
        if (ks == 0) { const f32x4 bb = *(const f32x4*)(a.in[7] + (size_t)l * 6144 + col); float* mp = mod + (size_t)(l * 3) * 6144 + col;
            *(f32x4*)mp = a0 + bb; *(f32x4*)(mp + 6144) = a1 + bb; *(f32x4*)(mp + 2 * 6144) = a2 + bb; }
    }
}

__device__ __forceinline__ void p0_prologue(const Args& a, LAS unsigned char* lds, int tid, int lane, int wave) {
    unsigned char* ws = a.ws;
    const int gw = blockIdx.x * 8 + wave, NGW = gridDim.x * 8;
    float* mod = (float*)(ws + WS_MOD);
    mod_items(a, 0, NL, gw, NGW, lane);
    { const int nlw = (int)gridDim.x > 160 ? 1 : NL;
      for (int lw = 0; lw < nlw; ++lw) { weights_layer(a, lds, lw, blockIdx.x, gridDim.x, tid, lane, wave); __syncthreads(); } }
    const int gt = blockIdx.x * 512 + tid, GT = gridDim.x * 512;
    { const f32x4* ck = (const f32x4*)a.in[3]; const f32x4* cv = (const f32x4*)a.in[4]; v2u* KC = (v2u*)(ws + WS_KC); v2u* VC = (v2u*)(ws + WS_VC);
      for (int i = gt; i < 524288 / 4; i += GT) { const f32x4 k = ck[i], v = cv[i]; KC[i] = (v2u){pk2(k[0], k[1]), pk2(k[2], k[3])}; VC[i] = (v2u){pk2(v[0], v[1]), pk2(v[2], v[3])}; }
      const f32x4* wsp = (const f32x4*)a.in[20]; v2u* WSP = (v2u*)(ws + WS_WSP);
      for (int i = gt; i < 262144 / 4; i += GT) { const f32x4 k = wsp[i]; WSP[i] = (v2u){pk2(k[0], k[1]), pk2(k[2], k[3])}; } }
    { bf16_t* T256 = (bf16_t*)(ws + WS_T256);
      for (int i = gt; i < 256 * 512; i += GT) { const int k = i >> 9, j = i & 511, n = j & 255, r = (k * n) & 255; const float fr = (float)r * (1.0f / 256.0f);
          const float v = (j >= 256) ? -__builtin_amdgcn_sinf(fr) : __builtin_amdgcn_cosf(fr); T256[i] = (bf16_t)f2bf(v * (1.0f / 128.0f)); }
      bf16_t* T1024 = (bf16_t*)(ws + WS_T1024);
      for (int i = gt; i < 1024 * 2048; i += GT) { const int k = i >> 11, j = i & 2047, n = j & 1023, r = (k * n) & 1023; const float fr = (float)r * (1.0f / 1024.0f);
          const float v = (j >= 1024) ? -__builtin_amdgcn_sinf(fr) : __builtin_amdgcn_cosf(fr); T1024[i] = (bf16_t)f2bf(v * (1.0f / 256.0f)); }
      float* rope = (float*)(ws + WS_ROPE);
      if (gt < 512) { const int pos = gt >> 3, f = gt & 7; const float inv = __builtin_amdgcn_exp2f(-(float)f * 1.6609640474436813f); float rev = (float)pos * inv * 0.15915494309189535f; rev -= floorf(rev);
          rope[pos * 16 + f] = __builtin_amdgcn_cosf(rev); rope[pos * 16 + 8 + f] = __builtin_amdgcn_sinf(rev); } }
}

__device__ __forceinline__ void norm_phase(const float* src0, const float* src1, const float* gnorm, const float* modl, int shi, int sci, bf16_t* XN, int lane, int wave) {
    const int gw = blockIdx.x * 8 + wave, NGW = gridDim.x * 8;
    for (int row = gw; row < M; row += NGW) {
        const float* xr = row < MCTX ? src0 + (size_t)row * 1024 : src1 + (size_t)(row - MCTX) * 1024;
        const int cond = row < MCTX ? 0 : 1 + ((row - MCTX) >> 10);
        const float* mp = modl + cond * 6144;
        f32x4 v[4]; float s = 0.f;
#pragma unroll
        for (int j = 0; j < 4; ++j) { v[j] = ((const f32x4*)xr)[lane + 64 * j]; s += (v[j][0] * v[j][0] + v[j][1] * v[j][1]) + (v[j][2] * v[j][2] + v[j][3] * v[j][3]); }
        const float rinv = rsqrtf(wave_sum(s) * (1.0f / 1024.0f) + 1e-6f);
#pragma unroll
        for (int j = 0; j < 4; ++j) { const int col = 4 * (lane + 64 * j);
            const f32x4 g = *(const f32x4*)(gnorm + col), sc = *(const f32x4*)(mp + sci * 1024 + col), sh = *(const f32x4*)(mp + shi * 1024 + col);
            const f32x4 h = v[j] * rinv * g * (sc + 1.0f) + sh;
            *(v2u*)(XN + (size_t)row * 1024 + col) = (v2u){pk2(h[0], h[1]), pk2(h[2], h[3])}; }
    }
}

__device__ __forceinline__ void cvec_layer(const Args& a, int l, int vw, int NW, int lane) {
    unsigned char* ws = a.ws; const float* modl = (const float*)(ws + WS_MOD) + (size_t)l * 3 * 6144;
    const bf16_t* WinT = (const bf16_t*)(ws + WS_WIN) + (size_t)l * 2304 * 1024; const bf16_t* W1T = (const bf16_t*)(ws + WS_W1) + (size_t)l * 4096 * 1024;
    float* cv1 = (float*)(ws + WS_CV1) + (size_t)l * 3 * 2304; float* cv2 = (float*)(ws + WS_CV2) + (size_t)l * 3 * 4096;
    for (int it = vw; it < 2304 + 4096; it += NW) {
        const bool first = it < 2304; const int n = first ? it : it - 2304; const int N = first ? 2304 : 4096;
        const bf16_t* wrow = (first ? WinT : W1T) + (size_t)n * 1024 + lane * 16; const float* sh = modl + (first ? 0 : 3 * 1024) + lane * 16; float* dst = first ? cv1 : cv2;
        const v4u w0 = *(const v4u*)wrow, w1 = *(const v4u*)(wrow + 8);
        float d[3];
#pragma unroll
        for (int c = 0; c < 3; ++c) { const f32x4 s0 = *(const f32x4*)(sh + c * 6144), s1 = *(const f32x4*)(sh + c * 6144 + 4), s2 = *(const f32x4*)(sh + c * 6144 + 8), s3 = *(const f32x4*)(sh + c * 6144 + 12);
            float t = bflo(w0[0]) * s0[0] + bfhi(w0[0]) * s0[1] + bflo(w0[1]) * s0[2] + bfhi(w0[1]) * s0[3];
            t += bflo(w0[2]) * s1[0] + bfhi(w0[2]) * s1[1] + bflo(w0[3]) * s1[2] + bfhi(w0[3]) * s1[3];
            t += bflo(w1[0]) * s2[0] + bfhi(w1[0]) * s2[1] + bflo(w1[1]) * s2[2] + bfhi(w1[1]) * s2[3];
            t += bflo(w1[2]) * s3[0] + bfhi(w1[2]) * s3[1] + bflo(w1[3]) * s3[2] + bfhi(w1[3]) * s3[3];
            d[c] = wave_sum(t); }
        if (lane == 0) { dst[n] = d[0]; dst[N + n] = d[1]; dst[2 * N + n] = d[2]; }
    }
}
__device__ __forceinline__ void prep_phase(const Args& a, int lane, int wave) {
    unsigned char* ws = a.ws; const float* modl = (const float*)(ws + WS_MOD);
    bf16_t* XN = (bf16_t*)(ws + WS_XN); float* rss = (float*)(ws + WS_RSS1);
    const int gw = blockIdx.x * 8 + wave, NGW = gridDim.x * 8;
    for (int row = gw; row < M; row += NGW) {
        const float* xr = row < MCTX ? a.in[0] + (size_t)row * 1024 : a.in[1] + (size_t)(row - MCTX) * 1024;
        const int cond = row < MCTX ? 0 : 1 + ((row - MCTX) >> 10);
        const float* mp = modl + cond * 6144;
        float s = 0.f;
#pragma unroll
        for (int j = 0; j < 4; ++j) { const int col = 4 * (lane + 64 * j); const f32x4 v = ((const f32x4*)xr)[lane + 64 * j]; s += (v[0] * v[0] + v[1] * v[1]) + (v[2] * v[2] + v[3] * v[3]);
            const f32x4 h = v * (*(const f32x4*)(a.in[8] + col)) * (*(const f32x4*)(mp + 1024 + col) + 1.0f);
            *(v2u*)(XN + (size_t)row * 1024 + col) = (v2u){pk2(h[0], h[1]), pk2(h[2], h[3])}; }
        s = wave_sum(s);
        if (lane < 16) rss[(size_t)row * 16 + lane] = lane == 0 ? s : 0.f;
    }
    cvec_layer(a, 0, gw, NGW, lane);
}

__device__ __forceinline__ void attn_item(LAS unsigned char* lds, const bf16_t* Z, const bf16_t* KC, const bf16_t* VC, bf16_t* MIXC, const float* ghead,
                                          int l, float lam, float lam_init, bool is_lat, int b, int h, int qb, int tid, int lane, int wave) {
    LAS bf16_t* Ks = (LAS bf16_t*)lds;
    LAS bf16_t* Vt = (LAS bf16_t*)(lds + 256 * 72 * 2);
    const int g = lane >> 4, li = lane & 15;
    const int seq0 = is_lat ? MCTX + b * 1024 : b * 256;
    const int qrow = seq0 + qb * 128 + wave * 16 + li;
    bf16x8 qf[2];
    qf[0] = *(const bf16x8*)(Z + (size_t)qrow * NZ + h * 64 + 8 * g);
    qf[1] = *(const bf16x8*)(Z + (size_t)qrow * NZ + h * 64 + 32 + 8 * g);
    f32x4 O[2][4];
#pragma unroll
    for (int c = 0; c < 2; ++c)
#pragma unroll
        for (int d = 0; d < 4; ++d) O[c][d] = (f32x4){0.f, 0.f, 0.f, 0.f};
    float lsum0 = 0.f, lsum1 = 0.f;
    const int ns = is_lat ? 5 : 1;
    v4u kreg[4], vreg[4];
#define ATT_LOAD(stg) do { const bf16_t* kb_; const bf16_t* vb_; int st_; \
        if (is_lat && (stg) == 0) { const size_t o_ = ((size_t)(b * 4 + l) * 256) * 256 + h * 64; kb_ = KC + o_; vb_ = VC + o_; st_ = 256; } \
        else { const int row_ = is_lat ? seq0 + ((stg) - 1) * 256 : seq0; kb_ = Z + (size_t)row_ * NZ + 256 + h * 64; vb_ = Z + (size_t)row_ * NZ + 512 + h * 64; st_ = NZ; } \
        _Pragma("unroll") for (int i_ = 0; i_ < 4; ++i_) { const int idx_ = tid + 512 * i_; kreg[i_] = *(const v4u*)(kb_ + (size_t)(idx_ >> 3) * st_ + (idx_ & 7) * 8); } \
        _Pragma("unroll") for (int i_ = 0; i_ < 2; ++i_) { const int idx_ = tid + 512 * i_, kp_ = idx_ >> 3, ch_ = idx_ & 7; vreg[2 * i_] = *(const v4u*)(vb_ + (size_t)(2 * kp_) * st_ + ch_ * 8); vreg[2 * i_ + 1] = *(const v4u*)(vb_ + (size_t)(2 * kp_ + 1) * st_ + ch_ * 8); } } while (0)
    ATT_LOAD(0);
#pragma unroll 1
    for (int s = 0; s < ns; ++s) {
#pragma unroll
        for (int i = 0; i < 4; ++i) { const int idx = tid + 512 * i; *(LAS v4u*)(Ks + (idx >> 3) * 72 + (idx & 7) * 8) = kreg[i]; }
#pragma unroll
        for (int i = 0; i < 2; ++i) { const int idx = tid + 512 * i, kp = idx >> 3, ch = idx & 7; const v4u v0 = vreg[2 * i], v1 = vreg[2 * i + 1];
#pragma unroll
            for (int e = 0; e < 4; ++e) { *(LAS unsigned*)(Vt + (ch * 8 + 2 * e) * 264 + 2 * kp) = (v0[e] & 0xffffu) | (v1[e] << 16); *(LAS unsigned*)(Vt + (ch * 8 + 2 * e + 1) * 264 + 2 * kp) = (v0[e] >> 16) | (v1[e] & 0xffff0000u); } }
        __syncthreads();
        if (s + 1 < ns) ATT_LOAD(s + 1);
#pragma unroll 1
        for (int kq = 0; kq < 4; ++kq) {
            const LAS bf16_t* Kq = Ks + kq * 64 * 72; const LAS bf16_t* Vq = Vt + kq * 64;
            f32x4 st[2][4];
#pragma unroll
            for (int kt = 0; kt < 4; ++kt)
#pragma unroll
                for (int c = 0; c < 2; ++c) { const bf16x8 af = *(const LAS bf16x8*)(Kq + (kt * 16 + li) * 72 + c * 32 + 8 * g); st[c][kt] = MFMA16(af, qf[c], ((f32x4){0.f, 0.f, 0.f, 0.f})); }
#pragma unroll
            for (int kt = 0; kt < 4; ++kt)
#pragma unroll
                for (int j = 0; j < 4; ++j) { const float p0 = __builtin_amdgcn_exp2f(st[0][kt][j]), p1 = __builtin_amdgcn_exp2f(st[1][kt][j]); lsum0 += p0; lsum1 += p1; st[0][kt][j] = p0; st[1][kt][j] = p1; }
#pragma unroll
            for (int ks = 0; ks < 2; ++ks) {
                bf16x8 pb[2];
#pragma unroll
                for (int c = 0; c < 2; ++c) { v4u w; w.x = pk2(st[c][2 * ks][0], st[c][2 * ks][1]); w.y = pk2(st[c][2 * ks][2], st[c][2 * ks][3]); w.z = pk2(st[c][2 * ks + 1][0], st[c][2 * ks + 1][1]); w.w = pk2(st[c][2 * ks + 1][2], st[c][2 * ks + 1][3]); pb[c] = __builtin_bit_cast(bf16x8, w); }
#pragma unroll
                for (int dt = 0; dt < 4; ++dt) { const LAS bf16_t* vp = Vq + (dt * 16 + li) * 264 + 32 * ks + 4 * g;
                    const v2u lo = *(const LAS v2u*)vp, hi = *(const LAS v2u*)(vp + 16);
                    const bf16x8 af = __builtin_bit_cast(bf16x8, ((v4u){lo.x, lo.y, hi.x, hi.y}));
                    O[0][dt] = MFMA16(af, pb[0], O[0][dt]); O[1][dt] = MFMA16(af, pb[1], O[1][dt]); }
            }
        }
        __syncthreads();
    }
#undef ATT_LOAD
    lsum0 += __shfl_xor(lsum0, 16); lsum0 += __shfl_xor(lsum0, 32); lsum1 += __shfl_xor(lsum1, 16); lsum1 += __shfl_xor(lsum1, 32);
    const float i0 = __builtin_amdgcn_rcpf(lsum0), i1 = lam * __builtin_amdgcn_rcpf(lsum1);
    float ssq = 0.f;
#pragma unroll
    for (int dt = 0; dt < 4; ++dt) { O[0][dt] = O[0][dt] * i0 - O[1][dt] * i1; ssq += (O[0][dt][0] * O[0][dt][0] + O[0][dt][1] * O[0][dt][1]) + (O[0][dt][2] * O[0][dt][2] + O[0][dt][3] * O[0][dt][3]); }
    ssq += __shfl_xor(ssq, 16); ssq += __shfl_xor(ssq, 32);
    const float rs = rsqrtf(ssq * (1.0f / 64.0f) + 1e-6f) * (1.0f - lam_init);
#pragma unroll
    for (int dt = 0; dt < 4; ++dt) { const f32x4 gh = *(const f32x4*)(ghead + dt * 16 + 4 * g); const f32x4 o = O[0][dt] * rs * gh;
        *(v2u*)(MIXC + (size_t)qrow * 1024 + h * 64 + dt * 16 + 4 * g) = (v2u){pk2(o[0], o[1]), pk2(o[2], o[3])}; }
}

__device__ __forceinline__ void gating_item(LAS unsigned char* lds, const bf16_t* Z, const bf16_t* WSP, bf16_t* MIXC, const float* g_sg, const float* b_sg, const float* b_sp,
                                            int l, int chunk, int tid, int lane, int wave) {
    LAS bf16_t* vnT = (LAS bf16_t*)lds;
    const int r0 = chunk * 128;
    bf16x8 afr[4][4];
    { const int gq_ = lane >> 4, li_ = lane & 15;
#pragma unroll
      for (int g = 0; g < 4; ++g)
#pragma unroll
          for (int ks = 0; ks < 4; ++ks) afr[g][ks] = *(const bf16x8*)(WSP + ((size_t)(l * 4 + g) * 128 + wave * 16 + li_) * 128 + ks * 32 + 8 * gq_); }
    { const int tp = tid >> 3, part = tid & 7;
      const v4u* src0 = (const v4u*)(Z + (size_t)(r0 + 2 * tp) * NZ + 1024 + part * 32); const v4u* src1 = (const v4u*)(Z + (size_t)(r0 + 2 * tp + 1) * NZ + 1024 + part * 32);
      v4u ra[4], rb[4]; float sa = 0.f, sb = 0.f;
#pragma unroll
      for (int i = 0; i < 4; ++i) { ra[i] = src0[i]; rb[i] = src1[i];
#pragma unroll
          for (int e = 0; e < 4; ++e) { sa += bflo(ra[i][e]) + bfhi(ra[i][e]); sb += bflo(rb[i][e]) + bfhi(rb[i][e]); } }
      sa += __shfl_xor(sa, 1); sa += __shfl_xor(sa, 2); sa += __shfl_xor(sa, 4); sb += __shfl_xor(sb, 1); sb += __shfl_xor(sb, 2); sb += __shfl_xor(sb, 4);
      const float ma = sa * (1.0f / 256.0f), mb = sb * (1.0f / 256.0f); float qa = 0.f, qb = 0.f;
#pragma unroll
      for (int i = 0; i < 4; ++i)
#pragma unroll
          for (int e = 0; e < 4; ++e) { const float d0 = bflo(ra[i][e]) - ma, d1 = bfhi(ra[i][e]) - ma, e0 = bflo(rb[i][e]) - mb, e1 = bfhi(rb[i][e]) - mb; qa += d0 * d0 + d1 * d1; qb += e0 * e0 + e1 * e1; }
      qa += __shfl_xor(qa, 1); qa += __shfl_xor(qa, 2); qa += __shfl_xor(qa, 4); qb += __shfl_xor(qb, 1); qb += __shfl_xor(qb, 2); qb += __shfl_xor(qb, 4);
      const float rsa = rsqrtf(qa * (1.0f / 256.0f) + 1e-6f), rsb = rsqrtf(qb * (1.0f / 256.0f) + 1e-6f);
#pragma unroll
      for (int i = 0; i < 4; ++i)
#pragma unroll
          for (int e = 0; e < 4; ++e) { const int ch = part * 32 + i * 8 + 2 * e;
              const float g0 = g_sg[l * 256 + ch], g1 = g_sg[l * 256 + ch + 1], b0 = b_sg[l * 256 + ch], b1 = b_sg[l * 256 + ch + 1];
              *(LAS unsigned*)(vnT + ch * 136 + 2 * tp) = pk2((bflo(ra[i][e]) - ma) * rsa * g0 + b0, (bflo(rb[i][e]) - mb) * rsb * g0 + b0);
              *(LAS unsigned*)(vnT + (ch + 1) * 136 + 2 * tp) = pk2((bfhi(ra[i][e]) - ma) * rsa * g1 + b1, (bfhi(rb[i][e]) - mb) * rsb * g1 + b1); } }
    __syncthreads();
    const int gq = lane >> 4, li = lane & 15, p0 = wave * 16;
#pragma unroll
    for (int g = 0; g < 4; ++g) {
        f32x4 acc[4];
#pragma unroll
        for (int nt = 0; nt < 4; ++nt) acc[nt] = (f32x4){0.f, 0.f, 0.f, 0.f};
#pragma unroll
        for (int ks = 0; ks < 4; ++ks) { const bf16x8 af = afr[g][ks];
#pragma unroll
            for (int nt = 0; nt < 4; ++nt) { const bf16x8 bfr = *(const LAS bf16x8*)(vnT + (g * 64 + nt * 16 + li) * 136 + ks * 32 + 8 * gq); acc[nt] = MFMA16(af, bfr, acc[nt]); } }
#pragma unroll
        for (int nt = 0; nt < 4; ++nt)
#pragma unroll
            for (int j = 0; j < 4; ++j) { const int p = p0 + 4 * gq + j, ch = g * 64 + nt * 16 + li; const float bs = b_sp[(l * 4 + g) * 128 + p];
                const float uu = bf2f(Z[(size_t)(r0 + p) * NZ + 768 + ch]);
                MIXC[(size_t)(r0 + p) * 1024 + 256 + ch] = (bf16_t)f2bf(uu * (acc[nt][j] + bs)); }
    }
    __syncthreads();
}

__device__ __forceinline__ void conv_item(LAS unsigned char* lds, const bf16_t* Z, bf16_t* MIXC, const float* w_dw, const float* b_dw, const float* g_cv, const float* b_cv,
                                          int l, int ci, int tid) {
    LAS bf16_t* hs = (LAS bf16_t*)lds;
    LAS float* ys = (LAS float*)(lds + 49152);
    const int r0 = ci * 64;
    int s0, L; if (r0 < MCTX) { s0 = r0 & ~255; L = 256; } else { s0 = MCTX + ((r0 - MCTX) & ~1023); L = 1024; }
    const int t0 = r0 - s0;
    { v4u av[6], gv[6];
#pragma unroll
      for (int i = 0; i < 6; ++i) { const int idx = tid + 512 * i, rr = idx >> 5, c8 = idx & 31, tt = t0 + rr - 15; av[i] = (v4u){0u, 0u, 0u, 0u}; gv[i] = av[i];
          if (idx < 94 * 32 && tt >= 0 && tt < L) { const bf16_t* p = Z + (size_t)(s0 + tt) * NZ + 1280 + c8 * 8; av[i] = *(const v4u*)p; gv[i] = *(const v4u*)(p + 256); } }
#pragma unroll
      for (int i = 0; i < 6; ++i) { const int idx = tid + 512 * i, rr = idx >> 5, c8 = idx & 31; v4u o;
#pragma unroll
          for (int e = 0; e < 4; ++e) o[e] = pk2(bflo(av[i][e]) * sigmoidf_(bflo(gv[i][e])), bfhi(av[i][e]) * sigmoidf_(bfhi(gv[i][e])));
          if (idx < 94 * 32) *(LAS v4u*)(hs + rr * 256 + c8 * 8) = o; } }
    __syncthreads();
    { const int ch = tid & 255, th = tid >> 8;
      float w[31];
#pragma unroll
      for (int j = 0; j < 31; ++j) w[j] = w_dw[(l * 31 + j) * 256 + ch];
      const float bias = b_dw[l * 256 + ch];
#pragma unroll 1
      for (int blk = 0; blk < 4; ++blk) { const int tb = th * 32 + blk * 8; float acc[8];
#pragma unroll
          for (int o = 0; o < 8; ++o) acc[o] = bias;
#pragma unroll
          for (int i = 0; i < 38; ++i) { const float hv = bf2f(hs[(tb + i) * 256 + ch]);
#pragma unroll
              for (int o = 0; o < 8; ++o) { const int j = i - o; if (j >= 0 && j < 31) acc[o] += hv * w[j]; } }
#pragma unroll
          for (int o = 0; o < 8; ++o) ys[(tb + o) * 256 + ch] = acc[o]; } }
    __syncthreads();
    { const int token = tid >> 3, part = tid & 7; const LAS f32x4* yp = (const LAS f32x4*)(ys + token * 256 + part * 32);
      f32x4 v[8]; float s = 0.f;
#pragma unroll
      for (int i = 0; i < 8; ++i) { v[i] = yp[i]; s += (v[i][0] + v[i][1]) + (v[i][2] + v[i][3]); }
      s += __shfl_xor(s, 1); s += __shfl_xor(s, 2); s += __shfl_xor(s, 4); const float mean = s * (1.0f / 256.0f); float q = 0.f;
#pragma unroll
      for (int i = 0; i < 8; ++i) { v[i] = v[i] - mean; q += (v[i][0] * v[i][0] + v[i][1] * v[i][1]) + (v[i][2] * v[i][2] + v[i][3] * v[i][3]); }
      q += __shfl_xor(q, 1); q += __shfl_xor(q, 2); q += __shfl_xor(q, 4); const float rstd = rsqrtf(q * (1.0f / 256.0f) + 1e-6f);
      bf16_t* op = MIXC + (size_t)(r0 + token) * 1024 + 512 + part * 32;
#pragma unroll
      for (int i = 0; i < 4; ++i) { const int ch = part * 32 + i * 8;
          const f32x4 g0 = *(const f32x4*)(g_cv + l * 256 + ch), g1 = *(const f32x4*)(g_cv + l * 256 + ch + 4), b0 = *(const f32x4*)(b_cv + l * 256 + ch), b1 = *(const f32x4*)(b_cv + l * 256 + ch + 4);
          f32x4 y0 = v[2 * i] * rstd * g0 + b0, y1 = v[2 * i + 1] * rstd * g1 + b1;
#pragma unroll
          for (int e = 0; e < 4; ++e) { y0[e] = y0[e] * sigmoidf_(y0[e]); y1[e] = y1[e] * sigmoidf_(y1[e]); }
          *(v4u*)(op + i * 8) = (v4u){pk2(y0[0], y0[1]), pk2(y0[2], y0[3]), pk2(y1[0], y1[1]), pk2(y1[2], y1[3])}; } }
    __syncthreads();
}

__device__ __forceinline__ void fourier_item(LAS unsigned char* lds, const bf16_t* Z, const bf16_t* T, bf16_t* MIXC, int L, int s0, int g, int rb, int tid, int lane, int wave) {
    LAS bf16_t* yt = (LAS bf16_t*)lds;
    const int gq = lane >> 4, li = lane & 15;
    const int krow = rb * 128 + wave * 16 + li; const int ldt = 2 * L;
    f32x4 acc[4];
#pragma unroll
    for (int nt = 0; nt < 4; ++nt) acc[nt] = (f32x4){0.f, 0.f, 0.f, 0.f};
    const int ns = L >> 8;
    v4u zr[8];
#define FOU_LOAD(stg) do { _Pragma("unroll") for (int i_ = 0; i_ < 2; ++i_) { const int idx_ = tid + 512 * i_, tp_ = idx_ >> 3, part_ = idx_ & 7; \
        const v4u* s0_ = (const v4u*)(Z + (size_t)(s0 + (stg) * 256 + 2 * tp_) * NZ + 1792 + (part_ >> 2) * 256 + g * 64 + (part_ & 3) * 16); const v4u* s1_ = (const v4u*)((const bf16_t*)s0_ + NZ); \
        zr[4 * i_] = s0_[0]; zr[4 * i_ + 1] = s0_[1]; zr[4 * i_ + 2] = s1_[0]; zr[4 * i_ + 3] = s1_[1]; } } while (0)
    FOU_LOAD(0);
#pragma unroll 1
    for (int s = 0; s < ns; ++s) {
#pragma unroll
        for (int i = 0; i < 2; ++i) { const int idx = tid + 512 * i, tp = idx >> 3, part = idx & 7; const v4u a0 = zr[4 * i], a1 = zr[4 * i + 1], b0 = zr[4 * i + 2], b1 = zr[4 * i + 3];
            LAS bf16_t* d = yt + (part * 16) * 264 + 2 * tp;
#pragma unroll
            for (int e = 0; e < 4; ++e) {
                *(LAS unsigned*)(d + (2 * e) * 264) = (a0[e] & 0xffffu) | (b0[e] << 16); *(LAS unsigned*)(d + (2 * e + 1) * 264) = (a0[e] >> 16) | (b0[e] & 0xffff0000u);
                *(LAS unsigned*)(d + (8 + 2 * e) * 264) = (a1[e] & 0xffffu) | (b1[e] << 16); *(LAS unsigned*)(d + (9 + 2 * e) * 264) = (a1[e] >> 16) | (b1[e] & 0xffff0000u); } }
        __syncthreads();
        if (s + 1 < ns) FOU_LOAD(s + 1);
#pragma unroll
        for (int cs = 0; cs < 2; ++cs) {
            bf16x8 af[8];
#pragma unroll
            for (int ks = 0; ks < 8; ++ks) af[ks] = *(const bf16x8*)(T + (size_t)krow * ldt + cs * L + s * 256 + ks * 32 + 8 * gq);
#pragma unroll
            for (int ks = 0; ks < 8; ++ks)
#pragma unroll
                for (int nt = 0; nt < 4; ++nt) { const bf16x8 bfr = *(const LAS bf16x8*)(yt + (cs * 64 + nt * 16 + li) * 264 + ks * 32 + 8 * gq); acc[nt] = MFMA16(af[ks], bfr, acc[nt]); }
        }
        __syncthreads();
    }
#undef FOU_LOAD
#pragma unroll
    for (int nt = 0; nt < 4; ++nt)
#pragma unroll
        for (int j = 0; j < 4; ++j) MIXC[(size_t)(s0 + rb * 128 + wave * 16 + 4 * gq + j) * 1024 + 768 + g * 64 + nt * 16 + li] = (bf16_t)f2bf(acc[nt][j]);
}

#ifndef MIXMASK
#define MIXMASK 15
#endif
__device__ __forceinline__ void mix_phase(const Args& a, LAS unsigned char* lds, const int l, const int tid_outer, int, int) {
    unsigned char* ws = a.ws;
    const bf16_t* Z = (const bf16_t*)(ws + WS_Z); bf16_t* MIXC = (bf16_t*)(ws + WS_MIXC);
    float d1 = 0.f, d2 = 0.f;
    for (int i = 0; i < 32; ++i) { d1 += a.in[13][l * 32 + i] * a.in[14][l * 32 + i]; d2 += a.in[15][l * 32 + i] * a.in[16][l * 32 + i]; }
    const float lam_init = 0.8f - 0.6f * __expf(-0.3f * (float)l);
    const float lam = __expf(d1) - __expf(d2) + lam_init;
    const int l_outer = l;
    unsigned* qctr = (unsigned*)(ws + WS_BAR) + 3584 + 64 * l;
    LAS int* qslot = (LAS int*)(lds + 131072 + 64);
    const int nstat = 2 * (int)gridDim.x <= 880 ? 2 : 0;
    for (int kq_ = 0;; ++kq_) {
        int it;
        if (kq_ < nstat) it = (int)blockIdx.x + kq_ * (int)gridDim.x;
        else {
            if (tid_outer == 0) *qslot = nstat * (int)gridDim.x + (int)__hip_atomic_fetch_add(qctr, 1u, __ATOMIC_RELAXED, __HIP_MEMORY_SCOPE_AGENT);
            __syncthreads();
            it = *qslot;
            __syncthreads();
        }
        if (it >= 880) break;
        int tid = tid_outer; asm volatile("" : "+v"(tid));
        const int lane = tid & 63, wave = __builtin_amdgcn_readfirstlane(tid >> 6);
        int l = l_outer; asm volatile("" : "+s"(l));
        if (it < 64) { if ((MIXMASK & 1) && !(MIXMASK & 16)) attn_item(lds, Z, (const bf16_t*)(ws + WS_KC), (const bf16_t*)(ws + WS_VC), MIXC, a.in[17] + l * 64, l, lam, lam_init, true, it >> 5, (it >> 3) & 3, it & 7, tid, lane, wave); }
        else if (it < 128) { const int r = it - 64; if (MIXMASK & 2) fourier_item(lds, Z, (const bf16_t*)(ws + WS_T1024), MIXC, 1024, MCTX + (r >> 5) * 1024, (r >> 3) & 3, r & 7, tid, lane, wave); }
        else if (it < 208) { if (MIXMASK & 4) gating_item(lds, Z, (const bf16_t*)(ws + WS_WSP), MIXC, a.in[18], a.in[19], a.in[21], l, it - 128, tid, lane, wave); }
        else if (it < 368) { if (MIXMASK & 8) conv_item(lds, Z, MIXC, a.in[22], a.in[23], a.in[24], a.in[25], l, it - 208, tid); }
        else if (it < 624) { const int r = it - 368; if ((MIXMASK & 1) && !(MIXMASK & 32)) attn_item(lds, Z, (const bf16_t*)(ws + WS_KC), (const bf16_t*)(ws + WS_VC), MIXC, a.in[17] + l * 64, l, lam, lam_init, false, r >> 3, (r >> 1) & 3, r & 1, tid, lane, wave); }
        else { const int r = it - 624; if (MIXMASK & 2) fourier_item(lds, Z, (const bf16_t*)(ws + WS_T256), MIXC, 256, (r >> 3) * 256, (r >> 1) & 3, r & 1, tid, lane, wave); }
    }
}

constexpr int N_PHASES = 1 + 7 * NL;
#ifndef REPEAT_KIND
#define REPEAT_KIND -1
#endif
#ifndef PHASE_MASK
#define PHASE_MASK 255
#endif
__global__ void __launch_bounds__(512, 2) fwd_megakernel(Args a) {
    extern __shared__ __attribute__((aligned(16))) unsigned char lds_raw[];
    LAS unsigned char* lds = (LAS unsigned char*)lds_raw;
    unsigned char* ws = a.ws;
    const bool coop = (a.ph_hi - a.ph_lo) > 1;
    XcdBarrier bar; bar.bar = (unsigned*)(ws + WS_BAR); bar.x = 0; bar.st = nullptr;
    if (coop) {
        if (threadIdx.x < 64) ((LAS unsigned*)(lds + 131072))[threadIdx.x] = 0u;
        __syncthreads();
        bar = xcd_barrier_post((unsigned*)(ws + WS_BAR), (volatile LAS unsigned*)(lds + 131072));
        if (a.ph_hi > 100000) cg::this_grid().sync();
    }
    const float* mod = (const float*)(ws + WS_MOD);
    bf16_t* XN = (bf16_t*)(ws + WS_XN); bf16_t* Zb = (bf16_t*)(ws + WS_Z); bf16_t* MIXC = (bf16_t*)(ws + WS_MIXC); bf16_t* HB = (bf16_t*)(ws + WS_HB);
    float* X1 = (float*)(ws + WS_X1); float* X = (float*)(ws + WS_X);
#if REPEAT_KIND >= 0
    const int nsteps = N_PHASES + (REPEAT_KIND == 7 ? 1 : NL);
    for (int step = 0; step < nsteps; ++step) {
        int ph;
        if (REPEAT_KIND == 7) ph = step == 0 ? 0 : step - 1;
        else if (step == 0) ph = 0;
        else { const int s_ = step - 1, l_ = s_ / 8, j_ = s_ % 8; ph = 1 + 7 * l_ + (j_ <= REPEAT_KIND ? j_ : j_ - 1); }
        const bool last_step = step + 1 >= nsteps;
#else
    for (int ph = a.ph_lo; ph < a.ph_hi; ++ph) {
        const bool last_step = ph + 1 >= a.ph_hi;
#endif
        int tid_raw = threadIdx.x; asm volatile("" : "+v"(tid_raw));
        const int tid = tid_raw, lane = tid & 63, wave = __builtin_amdgcn_readfirstlane(tid >> 6);
        if (ph == 0) { if (PHASE_MASK & 128) p0_prologue(a, lds, tid, lane, wave); }
        else {
            const int l = (ph - 1) / 7, k = (ph - 1) % 7;
            const float* modl = mod + (size_t)l * 3 * 6144;
            const float* xin0 = l == 0 ? a.in[0] : X; const float* xin1 = l == 0 ? a.in[1] : X + (size_t)MCTX * 1024;
            if (k == 4 || (k == 0 && l > 0)) continue;
            if (k == 0) { prep_phase(a, lane, wave); }
            else if (k == 1) { if (PHASE_MASK & 2) {
                pg8::Gemm g{XN, (const bf16_t*)(ws + WS_WIN) + (size_t)l * 2304 * 1024, M, NZ, DM}; pg8::StaticOrder S; S.init(M, NZ, gridDim.x, blockIdx.x);
                pg8::EpiG1 E{Zb, a.out + (size_t)M * 1024, a.out + (size_t)M * 1024 + (size_t)32 * 4 * 256 * 256, a.in[11] + l * 32, a.in[12] + l * 32, (const float*)(ws + WS_ROPE), l, (const float*)(ws + WS_RSS1), (const float*)(ws + WS_CV1) + (size_t)l * 3 * 2304, (const LAS float*)(lds + pg8::RSS_LDS_OFF)};
                pg8::gemm_phase<pg8::EpiG1, pg8::StaticOrder, true, true>(lds, g, S, E); }
            }
            else if (k == 2) { if (PHASE_MASK & 4) mix_phase(a, lds, l, tid, lane, wave); }
            else if (k == 3) { if (PHASE_MASK & 8) {
                pg8::Gemm g{MIXC, (const bf16_t*)(ws + WS_WOUT) + (size_t)l * 1024 * 1024, M, DM, DM}; pg8::StaticOrder S; S.init(M, DM, gridDim.x, blockIdx.x); S.wgm = 5;
                pg8::EpiRes E{a.in[0], a.in[1], l == 0 ? nullptr : (const bf16_t*)X, nullptr, (bf16_t*)X1, modl + 2 * 1024, XN, a.in[9] + l * 1024, modl + 4 * 1024, (float*)(ws + WS_RSS2)};
                pg8::gemm_phase<pg8::EpiRes, pg8::StaticOrder, true, true>(lds, g, S, E);
                if (l + 1 < NL && (int)blockIdx.x >= 160 && (int)gridDim.x > 160) weights_layer(a, lds, l + 1, blockIdx.x - 160, gridDim.x - 160, tid, lane, wave); }
            }
            else if (k == 4) { if (PHASE_MASK & 1) norm_phase(X1, X1 + (size_t)MCTX * 1024, a.in[9] + l * 1024, modl, 3, 4, XN, lane, wave); }
            else if (k == 5) { if (PHASE_MASK & 16) {
                pg8::Gemm g{XN, (const bf16_t*)(ws + WS_W1) + (size_t)l * 4096 * 1024, M, FF, DM}; pg8::StaticOrder S; S.init(M, FF, gridDim.x, blockIdx.x);
                pg8::EpiRelu2 E{HB, FF, (const float*)(ws + WS_RSS2), (const float*)(ws + WS_CV2) + (size_t)l * 3 * 4096, (const LAS float*)(lds + pg8::RSS_LDS_OFF)};
                pg8::gemm_phase<pg8::EpiRelu2, pg8::StaticOrder, true, true>(lds, g, S, E);
 }
            }
            else { if (PHASE_MASK & 32) {
                pg8::Gemm g{HB, (const bf16_t*)(ws + WS_W2) + (size_t)l * 1024 * 4096, M, DM, FF}; pg8::StaticOrder S; S.init(M, DM, gridDim.x, blockIdx.x); S.wgm = 5;
                pg8::EpiRes E{nullptr, nullptr, (const bf16_t*)X1, l == NL - 1 ? a.out : nullptr, l == NL - 1 ? nullptr : (bf16_t*)X, modl + 5 * 1024, l == NL - 1 ? nullptr : XN, a.in[8] + (l + 1 < NL ? l + 1 : l) * 1024, modl + 3 * 6144 + 1 * 1024, (float*)(ws + WS_RSS1)};
                pg8::gemm_phase<pg8::EpiRes, pg8::StaticOrder, true, true>(lds, g, S, E);
                if (l + 1 < NL && (int)blockIdx.x >= 160) cvec_layer(a, l + 1, (blockIdx.x - 160) * 8 + wave, (gridDim.x - 160) * 8, lane); }
            }
        }
        if (!last_step) { xcd_barrier(bar); }
    }
}

#ifndef MK_MULTI
#define MK_MULTI 0
#endif
extern "C" void kernel_launch(void* const* d_in, const int* in_sizes, int n_in, void* d_out, int out_size, void* d_ws, size_t ws_size, hipStream_t stream) {
    static int grid = 0;
    if (grid == 0) {
        if (n_in != 29 || ws_size < WS_END || out_size != 27262976) { fprintf(stderr, "kernel_launch: unexpected shapes: n_in %d ws %zu (need %zu) out %d\n", n_in, ws_size, (size_t)WS_END, out_size); grid = -1; return; }
        int dev = 0, cus = 0, per_cu = 0;
        if (hipGetDevice(&dev) != hipSuccess || hipDeviceGetAttribute(&cus, hipDeviceAttributeMultiprocessorCount, dev) != hipSuccess) { grid = -1; return; }
        if (hipFuncSetAttribute((const void*)fwd_megakernel, hipFuncAttributeMaxDynamicSharedMemorySize, LDS_BYTES) != hipSuccess) { fprintf(stderr, "kernel_launch: hipFuncSetAttribute failed\n"); grid = -1; return; }
        if (hipOccupancyMaxActiveBlocksPerMultiprocessor(&per_cu, (const void*)fwd_megakernel, 512, LDS_BYTES) != hipSuccess || per_cu < 1) { fprintf(stderr, "kernel_launch: occupancy query gave %d\n", per_cu); per_cu = 1; }
        (void)hipGetLastError();
        grid = cus * per_cu;
    }
    if (grid < 0) return;
    (void)hipMemsetAsync((char*)d_ws + WS_BAR, 0, WS_MOD + MOD_BYTES, stream);
    Args a{};
    for (int i = 0; i < 29; ++i) a.in[i] = (const float*)d_in[i];
    a.out = (float*)d_out; a.ws = (unsigned char*)d_ws;
#if MK_MULTI
    for (int ph = 0; ph < N_PHASES; ++ph) { a.ph_lo = ph; a.ph_hi = ph + 1; hipLaunchKernelGGL(fwd_megakernel, dim3(grid), dim3(512), LDS_BYTES, stream, a); }
#else
    a.ph_lo = 0; a.ph_hi = N_PHASES;
    void* args[] = {&a};
    hipError_t e = hipLaunchCooperativeKernel((const void*)fwd_megakernel, dim3(grid), dim3(512), args, LDS_BYTES, stream);
    if (e != hipSuccess) fprintf(stderr, "cooperative launch failed: %s (grid %d)\n", hipGetErrorString(e), grid);
#endif
}
```
